# Optimizing an MI355X kernel written in HIP

```python
import math
import jax
import jax.numpy as jnp
from jax import lax
import numpy as np

D_MODEL = 1024
BATCH = 1
SEQ = 16384
DEPTH = 4

CTX_LEN = 256
GRID_W = 64

N_HEADS = 16
N_KV_HEADS = 4
HEAD_DIM = 64
GROUP = N_HEADS // N_KV_HEADS
WINDOW = 128
BLOCK = 128
ROPE_BASE = 10000.0
ROPE_AXIS_DIM = HEAD_DIM // 2

GLA_HEADS = 4
GLA_DK = (D_MODEL // 2) // GLA_HEADS
GLA_DV = D_MODEL // GLA_HEADS
GLA_RANK = 16
GLA_NORMALIZER = 16.0
GLA_CHUNK = 64

D_FF = 4 * D_MODEL
N_MOD = 6
EPS = 1e-6

ATT_Q = N_HEADS * HEAD_DIM
ATT_KV = N_KV_HEADS * HEAD_DIM
GLA_K = GLA_HEADS * GLA_DK
GLA_V = GLA_HEADS * GLA_DV
IN_SIZES = (ATT_Q, ATT_KV, ATT_KV, GLA_K, GLA_K, GLA_V, GLA_V, 2 * GLA_RANK, D_MODEL, D_MODEL)
D_IN = ATT_Q + 2 * ATT_KV + 2 * GLA_K + 2 * GLA_V + 2 * GLA_RANK + 2 * D_MODEL

kernel_name = "hybrid_gqa_gla_prefix_dit"

NEG = -1e30


def rms_norm(x, g):
    xf = x.astype(jnp.float32)
    y = xf * lax.rsqrt(jnp.mean(xf * xf, axis=-1, keepdims=True) + EPS)
    return (y * g.astype(jnp.float32)).astype(x.dtype)


def modulate(h, shift, scale):
    return h * (1.0 + scale) + shift


def split_in(z):
    out, idx = [], 0
    for s in IN_SIZES:
        out.append(z[..., idx:idx + s])
        idx += s
    return out


def rope_1d(x, pos):
    d = x.shape[-1]
    half = d // 2
    inv = ROPE_BASE ** (-jnp.arange(half, dtype=jnp.float32) * 2.0 / d)
    ang = pos.astype(jnp.float32)[:, None] * inv[None, :]
    cos = jnp.cos(ang)[None, :, None, :]
    sin = jnp.sin(ang)[None, :, None, :]
    xf = x.astype(jnp.float32)
    x1, x2 = xf[..., :half], xf[..., half:]
    return jnp.concatenate([x1 * cos - x2 * sin, x2 * cos + x1 * sin], axis=-1).astype(x.dtype)


def rope_2d(x, row, col):
    return jnp.concatenate([rope_1d(x[..., :ROPE_AXIS_DIM], row),
                            rope_1d(x[..., ROPE_AXIS_DIM:], col)], axis=-1)


def window_attention(q, k, v, kc, vc, sink):
    B, N = q.shape[0], q.shape[1]
    L = kc.shape[1]
    nb = N // BLOCK
    scale = HEAD_DIM ** -0.5
    qb = q.reshape(B, nb, BLOCK, N_KV_HEADS, GROUP, HEAD_DIM)
    pad = ((0, 0), (BLOCK, BLOCK), (0, 0), (0, 0))
    kp = jnp.pad(k, pad).reshape(B, nb + 2, BLOCK, N_KV_HEADS, HEAD_DIM)
    vp = jnp.pad(v, pad).reshape(B, nb + 2, BLOCK, N_KV_HEADS, HEAD_DIM)
    kw = jnp.concatenate([kp[:, :-2], kp[:, 1:-1], kp[:, 2:]], axis=2)
    vw = jnp.concatenate([vp[:, :-2], vp[:, 1:-1], vp[:, 2:]], axis=2)
    s_loc = jnp.einsum('bnqkgd,bnskd->bnkgqs', qb, kw).astype(jnp.float32) * scale
    qpos = jnp.arange(nb)[:, None] * BLOCK + jnp.arange(BLOCK)[None, :]
    kpos = (jnp.arange(nb)[:, None] - 1) * BLOCK + jnp.arange(3 * BLOCK)[None, :]
    valid = (jnp.abs(qpos[:, :, None] - kpos[:, None, :]) <= WINDOW) \
        & (kpos[:, None, :] >= 0) & (kpos[:, None, :] < N)
    s_loc = jnp.where(valid[None, :, None, None], s_loc, NEG)
    s_ctx = jnp.einsum('bnqkgd,bckd->bnkgqc', qb, kc).astype(jnp.float32) * scale
    s_sink = jnp.broadcast_to(sink.astype(jnp.float32).reshape(1, 1, N_KV_HEADS, GROUP, 1, 1),
                              (B, nb, N_KV_HEADS, GROUP, BLOCK, 1))
    p = jax.nn.softmax(jnp.concatenate([s_loc, s_ctx, s_sink], axis=-1), axis=-1)
    p_loc = p[..., :3 * BLOCK].astype(v.dtype)
    p_ctx = p[..., 3 * BLOCK:3 * BLOCK + L].astype(v.dtype)
    o = jnp.einsum('bnkgqs,bnskd->bnqkgd', p_loc, vw) + jnp.einsum('bnkgqc,bckd->bnqkgd', p_ctx, vc)
    return o.reshape(B, N, ATT_Q)


def context_attention(qc, kc, vc, sink):
    B, L = qc.shape[0], qc.shape[1]
    scale = HEAD_DIM ** -0.5
    qg = qc.reshape(B, L, N_KV_HEADS, GROUP, HEAD_DIM)
    s = jnp.einsum('bqkgd,bckd->bkgqc', qg, kc).astype(jnp.float32) * scale
    s_sink = jnp.broadcast_to(sink.astype(jnp.float32).reshape(1, N_KV_HEADS, GROUP, 1, 1),
                              (B, N_KV_HEADS, GROUP, L, 1))
    p = jax.nn.softmax(jnp.concatenate([s, s_sink], axis=-1), axis=-1)[..., :L].astype(vc.dtype)
    o = jnp.einsum('bkgqc,bckd->bqkgd', p, vc)
    return o.reshape(B, L, ATT_Q)


def gla_chunked(q, k, v, g, s0):
    B, H, N, dk = q.shape
    dv = v.shape[-1]
    C = GLA_CHUNK
    nc = N // C
    q = q.reshape(B, H, nc, C, dk)
    k = k.reshape(B, H, nc, C, dk)
    v = v.reshape(B, H, nc, C, dv)
    b = jnp.cumsum(g.reshape(B, H, nc, C, dk), axis=3)
    b_last = b[..., -1:, :]
    q_in = q * jnp.exp(b)
    k_in = k * jnp.exp(-b)
    k_out = k * jnp.exp(b_last - b)
    a = jnp.einsum('bhnid,bhnjd->bhnij', q_in, k_in)
    a = jnp.where(jnp.tril(jnp.ones((C, C), dtype=bool)), a, 0.0)
    o_intra = jnp.einsum('bhnij,bhnje->bhnie', a, v)

    def step(S, inp):
        qi, ko, vi, dl = inp
        o = jnp.einsum('bhid,bhde->bhie', qi, S)
        S = S * dl[..., None] + jnp.einsum('bhjd,bhje->bhde', ko, vi)
        return S, o

    xs = (jnp.moveaxis(q_in, 2, 0), jnp.moveaxis(k_out, 2, 0), jnp.moveaxis(v, 2, 0),
          jnp.moveaxis(jnp.exp(b_last[..., 0, :]), 2, 0))
    s_fin, o_inter = lax.scan(step, s0, xs)
    o = o_intra + jnp.moveaxis(o_inter, 0, 2)
    return o.reshape(B, H, N, dv), s_fin


def gla_inputs(gq, gk, gv, ga, w_decay, b_decay):
    B, N = gq.shape[0], gq.shape[1]

    def heads(t, d):
        return t.astype(jnp.float32).reshape(B, N, GLA_HEADS, d).transpose(0, 2, 1, 3)

    q = heads(gq, GLA_DK) * (GLA_DK ** -0.5)
    k = heads(gk, GLA_DK)
    v = heads(gv, GLA_DV)
    g_f = jax.nn.log_sigmoid((ga[..., :GLA_RANK] @ w_decay[0] + b_decay[0]).astype(jnp.float32)) / GLA_NORMALIZER
    g_b = jax.nn.log_sigmoid((ga[..., GLA_RANK:] @ w_decay[1] + b_decay[1]).astype(jnp.float32)) / GLA_NORMALIZER
    return q, k, v, heads(g_f, GLA_DK), heads(g_b, GLA_DK)


def bidir_gla(q, k, v, g_f, g_b, s0_f, s0_b):
    o_f, s_f = gla_chunked(q, k, v, g_f, s0_f)
    flip = lambda t: jnp.flip(t, axis=2)
    o_b, s_b = gla_chunked(flip(q), flip(k), flip(v), flip(g_b), s0_b)
    return o_f + flip(o_b), s_f, s_b


def gla_output(o, gr, gain):
    B, H, N, dv = o.shape
    o = rms_norm(o.transpose(0, 2, 1, 3), gain).reshape(B, N, H * dv)
    return o.astype(gr.dtype) * jax.nn.silu(gr)


def squared_relu_mlp(h, w1, w2):
    return jnp.square(jax.nn.relu(h @ w1)) @ w2


def setup_inputs(seed: int = 0) -> dict:
    key = jax.random.key(seed)
    ks = jax.random.split(key, 20)
    nrm = lambda k, shape, s: jax.random.normal(k, shape, dtype=jnp.float32) * s
    D = D_MODEL
    return {
        "x": nrm(ks[0], (BATCH, SEQ, D), 1.0),
        "c": nrm(ks[1], (BATCH, D), 1.0),
        "ctx": nrm(ks[2], (BATCH, CTX_LEN, D), 1.0),
        "c_ctx": nrm(ks[3], (D,), 1.0),
        "w_mod": nrm(ks[4], (DEPTH, D, N_MOD * D), 0.5 * D ** -0.5),
        "b_mod": nrm(ks[5], (DEPTH, N_MOD * D), 0.02),
        "g_norm1": 1.0 + nrm(ks[6], (DEPTH, D), 0.1),
        "w_in": nrm(ks[7], (DEPTH, D, D_IN), D ** -0.5),
        "q_gain": 1.0 + nrm(ks[8], (DEPTH, HEAD_DIM), 0.1),
        "k_gain": 1.0 + nrm(ks[9], (DEPTH, HEAD_DIM), 0.1),
        "sink": nrm(ks[10], (DEPTH, N_HEADS), 0.5),
        "w_decay": nrm(ks[11], (DEPTH, 2, GLA_RANK, GLA_K), GLA_RANK ** -0.5),
        "b_decay": nrm(ks[12], (DEPTH, 2, GLA_K), 0.5),
        "gla_gain": 1.0 + nrm(ks[13], (DEPTH, GLA_DV), 0.1),
        "w_branch_attn": nrm(ks[14], (DEPTH, ATT_Q, D), ATT_Q ** -0.5),
        "w_branch_gla": nrm(ks[15], (DEPTH, GLA_V, D), GLA_V ** -0.5),
        "w_out": nrm(ks[16], (DEPTH, D, D), D ** -0.5),
        "g_norm2": 1.0 + nrm(ks[17], (DEPTH, D), 0.1),
        "w_ff1": nrm(ks[18], (DEPTH, D, D_FF), D ** -0.5),
        "w_ff2": nrm(ks[19], (DEPTH, D_FF, D), D_FF ** -0.5),
    }


def reference(x, c, ctx, c_ctx, w_mod, b_mod, g_norm1, w_in, q_gain, k_gain, sink, w_decay, b_decay,
              gla_gain, w_branch_attn, w_branch_gla, w_out, g_norm2, w_ff1, w_ff2):
    B, N = x.shape[0], x.shape[1]
    L = ctx.shape[1]
    ROWS = N // GRID_W
    row = jnp.repeat(jnp.arange(ROWS, dtype=jnp.int32), GRID_W)
    col = jnp.tile(jnp.arange(GRID_W, dtype=jnp.int32), ROWS)
    silu_c = jax.nn.silu(c)
    silu_cc = jax.nn.silu(c_ctx)
    xc = ctx
    s_zero = jnp.zeros((B, GLA_HEADS, GLA_DK, GLA_DV), jnp.float32)

    for l in range(DEPTH):
        last = l == DEPTH - 1
        mod = (silu_c @ w_mod[l] + b_mod[l])[:, None, :]
        mod_c = (silu_cc @ w_mod[l] + b_mod[l])[None, None, :]
        sh1, sc1, gt1, sh2, sc2, gt2 = jnp.split(mod, N_MOD, axis=-1)
        sh1c, sc1c, gt1c, sh2c, sc2c, gt2c = jnp.split(mod_c, N_MOD, axis=-1)

        h = modulate(rms_norm(x, g_norm1[l]), sh1, sc1)
        hc = modulate(rms_norm(xc, g_norm1[l]), sh1c, sc1c)
        aq, ak, av, gq, gk, gv, gr, ga, gate_a, gate_b = split_in(h @ w_in[l])
        aqc, akc, avc, gqc, gkc, gvc, grc, gac, gate_ac, gate_bc = split_in(hc @ w_in[l])

        q = rope_2d(rms_norm(aq.reshape(B, N, N_HEADS, HEAD_DIM), q_gain[l]), row, col)
        k = rope_2d(rms_norm(ak.reshape(B, N, N_KV_HEADS, HEAD_DIM), k_gain[l]), row, col)
        v = av.reshape(B, N, N_KV_HEADS, HEAD_DIM)
        kc = rms_norm(akc.reshape(B, L, N_KV_HEADS, HEAD_DIM), k_gain[l])
        vc = avc.reshape(B, L, N_KV_HEADS, HEAD_DIM)
        attn = window_attention(q, k, v, kc, vc, sink[l])

        qg_c, kg_c, vg_c, gf_c, gb_c = gla_inputs(gqc, gkc, gvc, gac, w_decay[l], b_decay[l])
        o_c, s_f, s_b = bidir_gla(qg_c, kg_c, vg_c, gf_c, gb_c, s_zero, s_zero)
        qg, kg, vg, gf, gb = gla_inputs(gq, gk, gv, ga, w_decay[l], b_decay[l])
        o_l, _, _ = bidir_gla(qg, kg, vg, gf, gb, s_f, s_b)
        gla = gla_output(o_l, gr, gla_gain[l])

        y = jax.nn.sigmoid(gate_a) * (attn @ w_branch_attn[l]) + jax.nn.sigmoid(gate_b) * (gla @ w_branch_gla[l])
        x = x + gt1 * (y @ w_out[l])

        x = x + gt2 * squared_relu_mlp(modulate(rms_norm(x, g_norm2[l]), sh2, sc2), w_ff1[l], w_ff2[l])

        if not last:
            qc = rms_norm(aqc.reshape(B, L, N_HEADS, HEAD_DIM), q_gain[l])
            attn_c = context_attention(qc, kc, vc, sink[l])
            gla_c = gla_output(o_c, grc, gla_gain[l])
            yc = jax.nn.sigmoid(gate_ac) * (attn_c @ w_branch_attn[l]) \
                + jax.nn.sigmoid(gate_bc) * (gla_c @ w_branch_gla[l])
            xc = xc + gt1c * (yc @ w_out[l])
            xc = xc + gt2c * squared_relu_mlp(modulate(rms_norm(xc, g_norm2[l]), sh2c, sc2c), w_ff1[l], w_ff2[l])

    return x
```

```cpp
#include <hip/hip_runtime.h>
#include <hip/hip_cooperative_groups.h>
#include <cstdio>
#include <cstdint>
namespace cg = cooperative_groups;

typedef unsigned short bf16_t;
typedef short bf16x8 __attribute__((ext_vector_type(8)));
typedef float f32x4 __attribute__((ext_vector_type(4)));
typedef unsigned u32x2 __attribute__((ext_vector_type(2)));
typedef unsigned u32x4 __attribute__((ext_vector_type(4)));

constexpr int NTOK = 16384, LCTX = 256, R = NTOK + LCTX, D = 1024, DFF = 4096, DEPTH = 4;
constexpr int D_IN_SRC = 6688;
constexpr int ZLD = 5376;
constexpr int ZQ = 0, ZK = 1024, ZGQ = 1280, ZGK = 1792, ZGR = 2304, ZGA = 3328, ZGB = 4352;
constexpr int WIN_ROWS = 6784;
constexpr int NCH = R / 64;
constexpr float EPS = 1e-6f;
constexpr float LOG2E = 1.4426950408889634f;

constexpr size_t al256(size_t x) { return (x + 255) & ~(size_t)255; }
constexpr size_t OFF_WIN = 0;
constexpr size_t OFF_WBA = OFF_WIN + al256((size_t)WIN_ROWS * D * 2);
constexpr size_t OFF_WBG = OFF_WBA + al256((size_t)D * D * 2);
constexpr size_t OFF_WO  = OFF_WBG + al256((size_t)D * D * 2);
constexpr size_t OFF_WF1 = OFF_WO  + al256((size_t)D * D * 2);
constexpr size_t OFF_WF2 = OFF_WF1 + al256((size_t)DFF * D * 2);
constexpr size_t OFF_H   = OFF_WF2 + al256((size_t)DFF * D * 2);
constexpr size_t OFF_Z   = OFF_H   + al256((size_t)R * D * 2);
constexpr size_t OFF_VT  = OFF_Z   + al256((size_t)R * ZLD * 2);
constexpr size_t OFF_GVT = OFF_VT  + al256((size_t)256 * R * 2);
constexpr size_t OFF_ST  = OFF_GVT + al256((size_t)1024 * R * 2);
constexpr size_t OFF_GA  = OFF_ST  + al256((size_t)2 * NCH * 4 * 256 * 128 * 2);
constexpr size_t OFF_DL  = OFF_GA  + al256((size_t)R * 32 * 4);
constexpr size_t OFF_MOD = OFF_DL  + al256((size_t)2 * NCH * 4 * 128 * 4);
constexpr size_t OFF_XC  = OFF_MOD + al256((size_t)DEPTH * 2 * 6 * D * 4);
constexpr size_t OFF_ROPE = OFF_XC + al256((size_t)LCTX * D * 4);
constexpr size_t WS_NEED = OFF_ROPE + al256((size_t)256 * 16 * 8);

struct Params {
  const float *x, *c, *ctx, *c_ctx, *w_mod, *b_mod, *g_norm1, *w_in, *q_gain, *k_gain, *sink, *w_decay, *b_decay,
      *gla_gain, *w_ba, *w_bg, *w_out, *g_norm2, *w_ff1, *w_ff2;
  float* out;
  unsigned char* ws;
};

__device__ __forceinline__ int opaque_tid() { int t = threadIdx.x; asm volatile("" : "+v"(t)); return t; }
__device__ __forceinline__ float bf2f(unsigned h) { return __uint_as_float(h << 16); }
__device__ __forceinline__ unsigned cvt_pk(float lo, float hi) { unsigned r; asm("v_cvt_pk_bf16_f32 %0, %1, %2" : "=v"(r) : "v"(lo), "v"(hi)); return r; }
__device__ __forceinline__ bf16_t f2bf(float f) { return (bf16_t)(cvt_pk(f, 0.f) & 0xffffu); }
__device__ __forceinline__ float bflo(unsigned u) { return __uint_as_float(u << 16); }
__device__ __forceinline__ float bfhi(unsigned u) { return __uint_as_float(u & 0xffff0000u); }
__device__ __forceinline__ float sigmoidf_(float x) { return 1.0f / (1.0f + __expf(-x)); }
__device__ __forceinline__ float siluf_(float x) { return x / (1.0f + __expf(-x)); }
__device__ __forceinline__ f32x4 mfma16(bf16x8 a, bf16x8 b, f32x4 c) { return __builtin_amdgcn_mfma_f32_16x16x32_bf16(a, b, c, 0, 0, 0); }

template <bool SWAP>
__device__ __forceinline__ void gemm_core(const bf16_t* __restrict__ A, int lda, const bf16_t* __restrict__ B, int ldb, int K,
                                          f32x4 (&acc)[4][4], unsigned char* smem) {
  const int tid = opaque_tid(), lane = tid & 63, wid = tid >> 6, wr = wid >> 1, wc = wid & 1, x = lane & 15, quad = lane >> 4;
  const int nk = K >> 6;
  u32x4 ra[4], rb[4];
  const int lrow = tid >> 3, lch = tid & 7;
  const bf16_t* ga = A + (size_t)lrow * lda + lch * 8;
  const bf16_t* gb = B + (size_t)lrow * ldb + lch * 8;
#pragma unroll
  for (int i = 0; i < 4; ++i) { ra[i] = *(const u32x4*)(ga + (size_t)(i * 32) * lda); rb[i] = *(const u32x4*)(gb + (size_t)(i * 32) * ldb); }
  const int soff = lrow * 128 + ((lch ^ (lrow & 7)) << 4);
#pragma unroll
  for (int i = 0; i < 4; ++i) { *(u32x4*)(smem + soff + i * 4096) = ra[i]; *(u32x4*)(smem + 16384 + soff + i * 4096) = rb[i]; }
  __syncthreads();
  for (int kt = 0; kt < nk; ++kt) {
    const bool more = (kt + 1) < nk;
    if (more) {
#pragma unroll
      for (int i = 0; i < 4; ++i) { ra[i] = *(const u32x4*)(ga + (size_t)(i * 32) * lda + (kt + 1) * 64); rb[i] = *(const u32x4*)(gb + (size_t)(i * 32) * ldb + (kt + 1) * 64); }
    }
    const unsigned char* sa = smem + (kt & 1) * 32768;
    const unsigned char* sb = sa + 16384;
#pragma unroll
    for (int kk = 0; kk < 2; ++kk) {
      bf16x8 af[4], bfv[4];
      const int ch = kk * 4 + quad;
#pragma unroll
      for (int i = 0; i < 4; ++i) {
        const int rowa = wr * 64 + i * 16 + x, rowb = wc * 64 + i * 16 + x;
        af[i] = *(const bf16x8*)(sa + rowa * 128 + ((ch ^ (rowa & 7)) << 4));
        bfv[i] = *(const bf16x8*)(sb + rowb * 128 + ((ch ^ (rowb & 7)) << 4));
      }
#pragma unroll
      for (int mi = 0; mi < 4; ++mi)
#pragma unroll
        for (int ni = 0; ni < 4; ++ni)
          acc[mi][ni] = SWAP ? mfma16(bfv[ni], af[mi], acc[mi][ni]) : mfma16(af[mi], bfv[ni], acc[mi][ni]);
    }
    if (more) {
      unsigned char* da = smem + ((kt + 1) & 1) * 32768;
#pragma unroll
      for (int i = 0; i < 4; ++i) { *(u32x4*)(da + soff + i * 4096) = ra[i]; *(u32x4*)(da + 16384 + soff + i * 4096) = rb[i]; }
    }
    __syncthreads();
  }
}

__device__ __forceinline__ void zero_acc(f32x4 (&acc)[4][4]) {
#pragma unroll
  for (int i = 0; i < 4; ++i)
#pragma unroll
    for (int j = 0; j < 4; ++j) acc[i][j] = (f32x4){0.f, 0.f, 0.f, 0.f};
}

__device__ void phase_gemm_in(const Params& p, int l, unsigned char* smem) {
  const bf16_t* H = (const bf16_t*)(p.ws + OFF_H);
  const bf16_t* W = (const bf16_t*)(p.ws + OFF_WIN);
  bf16_t* Z = (bf16_t*)(p.ws + OFF_Z);
  bf16_t* VT = (bf16_t*)(p.ws + OFF_VT);
  bf16_t* GVT = (bf16_t*)(p.ws + OFF_GVT);
  float* GA = (float*)(p.ws + OFF_GA);
  const float* ROPE = (const float*)(p.ws + OFF_ROPE);
  const int tid = opaque_tid(), lane = tid & 63, wid = tid >> 6, wr = wid >> 1, wc = wid & 1, x = lane & 15, quad = lane >> 4;
  constexpr int NTN = 53, NTM = R / 128;
  for (int t = blockIdx.x; t < NTN * NTM; t += gridDim.x) {
    const int grp = t / (8 * NTN), rem = t % (8 * NTN);
    const int gsz = (NTM - grp * 8) < 8 ? (NTM - grp * 8) : 8;
    const int tm = grp * 8 + rem % gsz, tn = rem / gsz;
    const int row0 = tm * 128;
    f32x4 acc[4][4];
    zero_acc(acc);
    const bf16_t* Ap = H + (size_t)row0 * D;
    const bf16_t* Bp = W + (size_t)tn * 128 * D;
    if (tn >= 42 && tn < 52) {
      gemm_core<false>(Ap, D, Bp, D, D, acc, smem);
#pragma unroll
      for (int ni = 0; ni < 4; ++ni) {
        const int n = (tn - 42) * 128 + wc * 64 + ni * 16 + x;
        bf16_t* dst = (n < 256) ? (VT + (size_t)n * R) : (GVT + (size_t)(n - 256) * R);
#pragma unroll
        for (int mi = 0; mi < 4; ++mi) {
          const int m = row0 + wr * 64 + mi * 16 + quad * 4;
          u32x2 w; w.x = cvt_pk(acc[mi][ni][0], acc[mi][ni][1]); w.y = cvt_pk(acc[mi][ni][2], acc[mi][ni][3]);
          *(u32x2*)(dst + m) = w;
        }
      }
    } else {
      gemm_core<true>(Ap, D, Bp, D, D, acc, smem);
      if (tn == 52) {
        if (wc == 0) {
#pragma unroll
          for (int mi = 0; mi < 4; ++mi) {
            const int row = row0 + wr * 64 + mi * 16 + x;
#pragma unroll
            for (int ni = 0; ni < 2; ++ni) *(f32x4*)(GA + (size_t)row * 32 + ni * 16 + quad * 4) = acc[mi][ni];
          }
        }
      } else if (tn < 10) {
        const bool isq = tn < 8;
        const float* gain = (isq ? p.q_gain : p.k_gain) + l * 64;
        f32x4 gv[4];
#pragma unroll
        for (int ni = 0; ni < 4; ++ni) gv[ni] = *(const f32x4*)(gain + ni * 16 + quad * 4);
        const float post = isq ? (0.125f * LOG2E) : 1.0f;
#pragma unroll
        for (int mi = 0; mi < 4; ++mi) {
          const int row = row0 + wr * 64 + mi * 16 + x;
          float ss = 0.f;
#pragma unroll
          for (int ni = 0; ni < 4; ++ni)
#pragma unroll
            for (int r = 0; r < 4; ++r) ss += acc[mi][ni][r] * acc[mi][ni][r];
          ss += __shfl_xor(ss, 16); ss += __shfl_xor(ss, 32);
          const float rstd = rsqrtf(ss * (1.0f / 64.0f) + EPS);
          f32x4 v[4];
#pragma unroll
          for (int ni = 0; ni < 4; ++ni) v[ni] = acc[mi][ni] * rstd * gv[ni];
          if (row < NTOK) {
            const int prow = row >> 6, pcol = row & 63;
            const float* t0 = ROPE + ((size_t)prow * 16 + quad * 4) * 2;
            const float* t1 = ROPE + ((size_t)pcol * 16 + quad * 4) * 2;
            const f32x4 a0 = *(const f32x4*)t0, a1 = *(const f32x4*)(t0 + 4), b0 = *(const f32x4*)t1, b1 = *(const f32x4*)(t1 + 4);
            const float cr[4] = {a0[0], a0[2], a1[0], a1[2]}, sr[4] = {a0[1], a0[3], a1[1], a1[3]};
            const float cc[4] = {b0[0], b0[2], b1[0], b1[2]}, sc[4] = {b0[1], b0[3], b1[1], b1[3]};
#pragma unroll
            for (int r = 0; r < 4; ++r) {
              const float x1 = v[0][r], x2 = v[1][r];
              v[0][r] = x1 * cr[r] - x2 * sr[r]; v[1][r] = x2 * cr[r] + x1 * sr[r];
              const float y1 = v[2][r], y2 = v[3][r];
              v[2][r] = y1 * cc[r] - y2 * sc[r]; v[3][r] = y2 * cc[r] + y1 * sc[r];
            }
          }
          bf16_t* dst = Z + (size_t)row * ZLD + tn * 128 + wc * 64 + quad * 4;
#pragma unroll
          for (int ni = 0; ni < 4; ++ni) {
            u32x2 w; w.x = cvt_pk(v[ni][0] * post, v[ni][1] * post); w.y = cvt_pk(v[ni][2] * post, v[ni][3] * post);
            *(u32x2*)(dst + ni * 16) = w;
          }
        }
      } else {
#pragma unroll
        for (int mi = 0; mi < 4; ++mi) {
          const int row = row0 + wr * 64 + mi * 16 + x;
          bf16_t* dst = Z + (size_t)row * ZLD + tn * 128 + wc * 64 + quad * 4;
#pragma unroll
          for (int ni = 0; ni < 4; ++ni) {
            u32x2 w; w.x = cvt_pk(acc[mi][ni][0], acc[mi][ni][1]); w.y = cvt_pk(acc[mi][ni][2], acc[mi][ni][3]);
            *(u32x2*)(dst + ni * 16) = w;
          }
        }
      }
    }
  }
}

template <int MODE>
__device__ void phase_gemm(const Params& p, int l, int ntm, const bf16_t* A, int lda, const bf16_t* W, int K, int ntn,
                           int gate_idx, const float* xsrc_lat, const float* xsrc_ctx, unsigned char* smem) {
  const int tid = opaque_tid(), lane = tid & 63, wid = tid >> 6, wr = wid >> 1, wc = wid & 1, x = lane & 15, quad = lane >> 4;
  bf16_t* Z = (bf16_t*)(p.ws + OFF_Z);
  bf16_t* Hb = (bf16_t*)(p.ws + OFF_H);
  float* XC = (float*)(p.ws + OFF_XC);
  const float* MOD = (const float*)(p.ws + OFF_MOD);
  for (int t = blockIdx.x; t < ntm * ntn; t += gridDim.x) {
    const int grp = t / (8 * ntn), rem = t % (8 * ntn);
    const int gsz = (ntm - grp * 8) < 8 ? (ntm - grp * 8) : 8;
    const int tm = grp * 8 + rem % gsz, tn = rem / gsz;
    const int row0 = tm * 128, col0 = tn * 128;
    f32x4 acc[4][4];
    zero_acc(acc);
    if (MODE == 0) {
      gemm_core<true>(Z + (size_t)row0 * ZLD + ZQ, ZLD, (const bf16_t*)(p.ws + OFF_WBA) + (size_t)col0 * D, D, D, acc, smem);
      u32x2 y1[4][4];
#pragma unroll
      for (int mi = 0; mi < 4; ++mi) {
        const int row = row0 + wr * 64 + mi * 16 + x;
        const bf16_t* g = Z + (size_t)row * ZLD + ZGA + col0 + wc * 64 + quad * 4;
#pragma unroll
        for (int ni = 0; ni < 4; ++ni) {
          const u32x2 gg = *(const u32x2*)(g + ni * 16);
          y1[mi][ni].x = cvt_pk(acc[mi][ni][0] * sigmoidf_(bflo(gg.x)), acc[mi][ni][1] * sigmoidf_(bfhi(gg.x)));
          y1[mi][ni].y = cvt_pk(acc[mi][ni][2] * sigmoidf_(bflo(gg.y)), acc[mi][ni][3] * sigmoidf_(bfhi(gg.y)));
        }
      }
      zero_acc(acc);
      gemm_core<true>(Z + (size_t)row0 * ZLD + ZGR, ZLD, (const bf16_t*)(p.ws + OFF_WBG) + (size_t)col0 * D, D, D, acc, smem);
#pragma unroll
      for (int mi = 0; mi < 4; ++mi) {
        const int row = row0 + wr * 64 + mi * 16 + x;
        const bf16_t* g = Z + (size_t)row * ZLD + ZGB + col0 + wc * 64 + quad * 4;
        bf16_t* dst = Hb + (size_t)row * D + col0 + wc * 64 + quad * 4;
#pragma unroll
        for (int ni = 0; ni < 4; ++ni) {
          const u32x2 gg = *(const u32x2*)(g + ni * 16);
          const float y0 = bflo(y1[mi][ni].x) + sigmoidf_(bflo(gg.x)) * acc[mi][ni][0];
          const float y1f = bfhi(y1[mi][ni].x) + sigmoidf_(bfhi(gg.x)) * acc[mi][ni][1];
          const float y2 = bflo(y1[mi][ni].y) + sigmoidf_(bflo(gg.y)) * acc[mi][ni][2];
          const float y3 = bfhi(y1[mi][ni].y) + sigmoidf_(bfhi(gg.y)) * acc[mi][ni][3];
          u32x2 w; w.x = cvt_pk(y0, y1f); w.y = cvt_pk(y2, y3);
          *(u32x2*)(dst + ni * 16) = w;
        }
      }
    } else {
      gemm_core<true>(A + (size_t)row0 * lda, lda, W + (size_t)col0 * K, K, K, acc, smem);
      if (MODE == 1) {
        const bool isctx = row0 >= NTOK;
        const float* gt = MOD + ((size_t)(l * 2 + (isctx ? 1 : 0)) * 6 + gate_idx) * D + col0 + wc * 64 + quad * 4;
        f32x4 gv[4];
#pragma unroll
        for (int ni = 0; ni < 4; ++ni) gv[ni] = *(const f32x4*)(gt + ni * 16);
#pragma unroll
        for (int mi = 0; mi < 4; ++mi) {
          const int row = row0 + wr * 64 + mi * 16 + x;
          const int cofs = col0 + wc * 64 + quad * 4;
          const float* src = isctx ? (xsrc_ctx + (size_t)(row - NTOK) * D + cofs) : (xsrc_lat + (size_t)row * D + cofs);
          float* dst = isctx ? (XC + (size_t)(row - NTOK) * D + cofs) : (p.out + (size_t)row * D + cofs);
#pragma unroll
          for (int ni = 0; ni < 4; ++ni) {
            const f32x4 xv = *(const f32x4*)(src + ni * 16);
            *(f32x4*)(dst + ni * 16) = xv + gv[ni] * acc[mi][ni];
          }
        }
      } else {
        bf16_t* U = Z;
#pragma unroll
        for (int mi = 0; mi < 4; ++mi) {
          const int row = row0 + wr * 64 + mi * 16 + x;
          bf16_t* dst = U + (size_t)row * DFF + col0 + wc * 64 + quad * 4;
#pragma unroll
          for (int ni = 0; ni < 4; ++ni) {
            f32x4 v = acc[mi][ni];
#pragma unroll
            for (int r = 0; r < 4; ++r) { const float a = fmaxf(v[r], 0.f); v[r] = a * a; }
            u32x2 w; w.x = cvt_pk(v[0], v[1]); w.y = cvt_pk(v[2], v[3]);
            *(u32x2*)(dst + ni * 16) = w;
          }
        }
      }
    }
  }
}

__device__ __forceinline__ int win_src_col(int n) {
  if (n < 1280) return n;
  if (n < 1792) return 1536 + (n - 1280);
  if (n < 2304) return 2048 + (n - 1792);
  if (n < 3328) return 3584 + (n - 2304);
  if (n < 4352) return 4640 + (n - 3328);
  if (n < 5376) return 5664 + (n - 4352);
  if (n < 5632) return 1280 + (n - 5376);
  if (n < 6656) return 2560 + (n - 5632);
  if (n < 6688) return 4608 + (n - 6656);
  return -1;
}

__device__ __forceinline__ void convert_tile(const float* __restrict__ src, int ld_src, int k0, int sc0, int sc1, bf16_t* __restrict__ dst, int K, int n0,
                                             unsigned char* smem) {
  float* tile = (float*)smem;
  const int tid = opaque_tid();
  __syncthreads();
#pragma unroll
  for (int i = 0; i < 4; ++i) {
    const int k = (tid >> 4) + i * 16, c4 = (tid & 15) * 4;
    const int sc = (c4 < 32) ? sc0 : sc1;
    f32x4 v = (f32x4){0.f, 0.f, 0.f, 0.f};
    if (sc >= 0) v = *(const f32x4*)(src + (size_t)(k0 + k) * ld_src + sc + (c4 & 31));
    tile[k * 65 + c4 + 0] = v[0]; tile[k * 65 + c4 + 1] = v[1]; tile[k * 65 + c4 + 2] = v[2]; tile[k * 65 + c4 + 3] = v[3];
  }
  __syncthreads();
#pragma unroll
  for (int i = 0; i < 2; ++i) {
    const int id = tid + i * 256, n = id >> 3, kc = id & 7;
    u32x4 w;
    w.x = cvt_pk(tile[(kc * 8 + 0) * 65 + n], tile[(kc * 8 + 1) * 65 + n]);
    w.y = cvt_pk(tile[(kc * 8 + 2) * 65 + n], tile[(kc * 8 + 3) * 65 + n]);
    w.z = cvt_pk(tile[(kc * 8 + 4) * 65 + n], tile[(kc * 8 + 5) * 65 + n]);
    w.w = cvt_pk(tile[(kc * 8 + 6) * 65 + n], tile[(kc * 8 + 7) * 65 + n]);
    *(u32x4*)(dst + (size_t)(n0 + n) * K + k0 + kc * 8) = w;
  }
}

constexpr int CV_IN = (WIN_ROWS / 64) * (D / 64);
constexpr int CV_SQ = (D / 64) * (D / 64);
constexpr int CV_FF = (DFF / 64) * (D / 64);
constexpr int CV_TOTAL = CV_IN + 3 * CV_SQ + 2 * CV_FF;

__device__ void convert_task(const Params& p, int l, int t, unsigned char* smem) {
  if (t < CV_IN) {
    const int nt = t / 16, kt = t % 16, n0 = nt * 64;
    convert_tile(p.w_in + (size_t)l * D * D_IN_SRC, D_IN_SRC, kt * 64, win_src_col(n0), win_src_col(n0 + 32), (bf16_t*)(p.ws + OFF_WIN), D, n0, smem);
    return;
  }
  t -= CV_IN;
  if (t < 3 * CV_SQ) {
    const int which = t / CV_SQ, tt = t % CV_SQ, nt = tt / 16, kt = tt % 16, n0 = nt * 64;
    const float* src = (which == 0 ? p.w_ba : which == 1 ? p.w_bg : p.w_out) + (size_t)l * D * D;
    bf16_t* dst = (bf16_t*)(p.ws + (which == 0 ? OFF_WBA : which == 1 ? OFF_WBG : OFF_WO));
    convert_tile(src, D, kt * 64, n0, n0 + 32, dst, D, n0, smem);
    return;
  }
  t -= 3 * CV_SQ;
  if (t < CV_FF) {
    const int nt = t / 16, kt = t % 16, n0 = nt * 64;
    convert_tile(p.w_ff1 + (size_t)l * D * DFF, DFF, kt * 64, n0, n0 + 32, (bf16_t*)(p.ws + OFF_WF1), D, n0, smem);
    return;
  }
  t -= CV_FF;
  {
    const int nt = t / 64, kt = t % 64, n0 = nt * 64;
    convert_tile(p.w_ff2 + (size_t)l * DFF * D, D, kt * 64, n0, n0 + 32, (bf16_t*)(p.ws + OFF_WF2), DFF, n0, smem);
  }
}

constexpr int MOD_TASKS = DEPTH * 24;
__device__ void mod_task(const Params& p, int t, unsigned char* smem) {
  float* sc = (float*)smem;
  const int tid = opaque_tid();
  __syncthreads();
  for (int i = tid; i < D; i += 256) { sc[i] = siluf_(p.c[i]); sc[D + i] = siluf_(p.c_ctx[i]); }
  __syncthreads();
  const int l = t / 24, col = (t % 24) * 256 + tid;
  const float* w = p.w_mod + (size_t)l * D * 6 * D + col;
  float a0 = 0.f, a1 = 0.f;
#pragma unroll 8
  for (int k = 0; k < D; ++k) { const float wv = w[(size_t)k * 6 * D]; a0 += sc[k] * wv; a1 += sc[D + k] * wv; }
  const float b = p.b_mod[l * 6 * D + col];
  float* MOD = (float*)(p.ws + OFF_MOD);
  MOD[(size_t)(l * 2 + 0) * 6 * D + col] = a0 + b;
  MOD[(size_t)(l * 2 + 1) * 6 * D + col] = a1 + b;
}
__device__ void rope_task(const Params& p, int t) {
  const int id = t * 256 + opaque_tid(), pos = id >> 4, i = id & 15;
  const double inv = exp2(-(double)i * (13.287712379549449 / 16.0));
  const double rev = (double)pos * inv * 0.15915494309189535;
  const float fr = (float)(rev - floor(rev));
  float* ROPE = (float*)(p.ws + OFF_ROPE);
  ROPE[id * 2 + 0] = __builtin_amdgcn_cosf(fr);
  ROPE[id * 2 + 1] = __builtin_amdgcn_sinf(fr);
}

__device__ void norm_task(const Params& p, int l, int t, int which, const float* xlat, const float* xctx) {
  const int tid = opaque_tid(), lane = tid & 63, wid = tid >> 6;
  const float* MOD = (const float*)(p.ws + OFF_MOD);
  bf16_t* H = (bf16_t*)(p.ws + OFF_H);
  const float* g = (which == 0 ? p.g_norm1 : p.g_norm2) + l * D;
  const bool isctx = t * 16 >= NTOK;
  const float* sh = MOD + ((size_t)(l * 2 + (isctx ? 1 : 0)) * 6 + which * 3 + 0) * D;
  const float* sc = sh + D;
  f32x4 gm[4], shv[4];
#pragma unroll
  for (int j = 0; j < 4; ++j) {
    const int c = j * 256 + lane * 4;
    const f32x4 gg = *(const f32x4*)(g + c), s = *(const f32x4*)(sc + c);
    gm[j] = gg * (s + 1.0f); shv[j] = *(const f32x4*)(sh + c);
  }
#pragma unroll
  for (int it = 0; it < 4; ++it) {
    const int row = t * 16 + it * 4 + wid;
    const float* xr = isctx ? (xctx + (size_t)(row - NTOK) * D) : (xlat + (size_t)row * D);
    f32x4 v[4];
    float ss = 0.f;
#pragma unroll
    for (int j = 0; j < 4; ++j) { v[j] = *(const f32x4*)(xr + j * 256 + lane * 4); ss += v[j][0] * v[j][0] + v[j][1] * v[j][1] + v[j][2] * v[j][2] + v[j][3] * v[j][3]; }
#pragma unroll
    for (int o = 32; o >= 1; o >>= 1) ss += __shfl_xor(ss, o);
    const float rstd = rsqrtf(ss * (1.0f / D) + EPS);
#pragma unroll
    for (int j = 0; j < 4; ++j) {
      const f32x4 h = v[j] * rstd * gm[j] + shv[j];
      u32x2 w; w.x = cvt_pk(h[0], h[1]); w.y = cvt_pk(h[2], h[3]);
      *(u32x2*)(H + (size_t)row * D + j * 256 + lane * 4) = w;
    }
  }
}

__device__ void attn_task(const Params& p, int l, int qb, int h, unsigned char* smem) {
  bf16_t* Z = (bf16_t*)(p.ws + OFF_Z);
  const bf16_t* VT = (const bf16_t*)(p.ws + OFF_VT);
  const int tid = opaque_tid(), lane = tid & 63, wid = tid >> 6, x = lane & 15, quad = lane >> 4;
  const int kh = h >> 2;
  const bool ctxq = qb >= (NTOK / 128);
  int lo = 0, nloc = 0;
  if (!ctxq) {
    lo = (qb - 1) * 128; if (lo < 0) lo = 0;
    int hi = (qb + 2) * 128; if (hi > NTOK) hi = NTOK;
    nloc = (hi - lo) >> 6;
  }
  const int ntiles = nloc + 4;
  unsigned char* sK = smem;
  unsigned char* sV = smem + 8192;
  bf16x8 qf[2][2];
#pragma unroll
  for (int qt = 0; qt < 2; ++qt)
#pragma unroll
    for (int kk = 0; kk < 2; ++kk)
      qf[qt][kk] = *(const bf16x8*)(Z + (size_t)(qb * 128 + wid * 32 + qt * 16 + x) * ZLD + ZQ + h * 64 + kk * 32 + quad * 8);
  const float sinkv = p.sink[l * 16 + h] * LOG2E;
  float mrun[2] = {sinkv, sinkv}, lrun[2];
  lrun[0] = lrun[1] = (quad == 0) ? 1.0f : 0.0f;
  f32x4 o[2][4];
#pragma unroll
  for (int qt = 0; qt < 2; ++qt)
#pragma unroll
    for (int dt = 0; dt < 4; ++dt) o[qt][dt] = (f32x4){0.f, 0.f, 0.f, 0.f};

  u32x4 rk[2], rv[2];
  auto gload = [&](int ti) {
    const int start = (ti < nloc) ? (lo + ti * 64) : (NTOK + (ti - nloc) * 64);
#pragma unroll
    for (int i = 0; i < 2; ++i) {
      const int id = tid + i * 256, rr = id >> 3, ch = id & 7;
      rk[i] = *(const u32x4*)(Z + (size_t)(start + rr) * ZLD + ZK + kh * 64 + ch * 8);
      rv[i] = *(const u32x4*)(VT + (size_t)(kh * 64 + rr) * R + start + ch * 8);
    }
  };
  gload(0);
  for (int ti = 0; ti < ntiles; ++ti) {
    __syncthreads();
#pragma unroll
    for (int i = 0; i < 2; ++i) {
      const int id = tid + i * 256, rr = id >> 3, ch = id & 7;
      *(u32x4*)(sK + rr * 128 + ((ch ^ (rr & 7)) << 4)) = rk[i];
      *(u32x4*)(sV + rr * 144 + ch * 16) = rv[i];
    }
    __syncthreads();
    const bool local = ti < nloc;
    const int start = local ? (lo + ti * 64) : 0;
    if (ti + 1 < ntiles) gload(ti + 1);
    f32x4 st[2][4];
#pragma unroll
    for (int t = 0; t < 4; ++t) {
      bf16x8 kf[2];
#pragma unroll
      for (int kk = 0; kk < 2; ++kk) { const int rr = t * 16 + x, ch = kk * 4 + quad; kf[kk] = *(const bf16x8*)(sK + rr * 128 + ((ch ^ (rr & 7)) << 4)); }
#pragma unroll
      for (int qt = 0; qt < 2; ++qt) {
        f32x4 a = (f32x4){0.f, 0.f, 0.f, 0.f};
        a = mfma16(kf[0], qf[qt][0], a);
        a = mfma16(kf[1], qf[qt][1], a);
        st[qt][t] = a;
      }
    }
    if (local) {
#pragma unroll
      for (int qt = 0; qt < 2; ++qt) {
        const int qpos = qb * 128 + wid * 32 + qt * 16 + x;
#pragma unroll
        for (int t = 0; t < 4; ++t)
#pragma unroll
          for (int r = 0; r < 4; ++r) {
            const int dd = qpos - (start + t * 16 + quad * 4 + r);
            if (dd > 128 || dd < -128) st[qt][t][r] = -1e30f;
          }
      }
    }
    bf16x8 pb[2][2];
#pragma unroll
    for (int qt = 0; qt < 2; ++qt) {
      float mx = st[qt][0][0];
#pragma unroll
      for (int t = 0; t < 4; ++t)
#pragma unroll
        for (int r = 0; r < 4; ++r) mx = fmaxf(mx, st[qt][t][r]);
      mx = fmaxf(mx, __shfl_xor(mx, 16)); mx = fmaxf(mx, __shfl_xor(mx, 32));
      const float mnew = fmaxf(mrun[qt], mx);
      const float alpha = exp2f(mrun[qt] - mnew);
      mrun[qt] = mnew;
      float ps = 0.f;
#pragma unroll
      for (int t = 0; t < 4; ++t)
#pragma unroll
        for (int r = 0; r < 4; ++r) { const float e = exp2f(st[qt][t][r] - mnew); st[qt][t][r] = e; ps += e; }
      lrun[qt] = lrun[qt] * alpha + ps;
#pragma unroll
      for (int dt = 0; dt < 4; ++dt) o[qt][dt] *= alpha;
#pragma unroll
      for (int hh = 0; hh < 2; ++hh) {
        u32x4 w;
        w.x = cvt_pk(st[qt][2 * hh][0], st[qt][2 * hh][1]); w.y = cvt_pk(st[qt][2 * hh][2], st[qt][2 * hh][3]);
        w.z = cvt_pk(st[qt][2 * hh + 1][0], st[qt][2 * hh + 1][1]); w.w = cvt_pk(st[qt][2 * hh + 1][2], st[qt][2 * hh + 1][3]);
        pb[qt][hh] = __builtin_bit_cast(bf16x8, w);
      }
    }
#pragma unroll
    for (int dt = 0; dt < 4; ++dt)
#pragma unroll
      for (int hh = 0; hh < 2; ++hh) {
        const unsigned char* vr = sV + (dt * 16 + x) * 144 + quad * 8;
        const u32x2 v0 = *(const u32x2*)(vr + (2 * hh) * 32), v1 = *(const u32x2*)(vr + (2 * hh + 1) * 32);
        u32x4 w; w.x = v0.x; w.y = v0.y; w.z = v1.x; w.w = v1.y;
        const bf16x8 va = __builtin_bit_cast(bf16x8, w);
#pragma unroll
        for (int qt = 0; qt < 2; ++qt) o[qt][dt] = mfma16(va, pb[qt][hh], o[qt][dt]);
      }
  }
#pragma unroll
  for (int qt = 0; qt < 2; ++qt) {
    float lt = lrun[qt];
    lt += __shfl_xor(lt, 16); lt += __shfl_xor(lt, 32);
    const float inv = 1.0f / lt;
    bf16_t* dst = Z + (size_t)(qb * 128 + wid * 32 + qt * 16 + x) * ZLD + ZQ + h * 64 + quad * 4;
#pragma unroll
    for (int dt = 0; dt < 4; ++dt) {
      u32x2 w; w.x = cvt_pk(o[qt][dt][0] * inv, o[qt][dt][1] * inv); w.y = cvt_pk(o[qt][dt][2] * inv, o[qt][dt][3] * inv);
      *(u32x2*)(dst + dt * 16) = w;
    }
  }
}

__device__ __forceinline__ size_t st_index(int dir, int c, int h) { return ((size_t)(dir * NCH + c) * 4 + h) * (256 * 128); }

template <int DIR>
__device__ __forceinline__ float gla_g1_scan(const float* sga, const float (&w)[16], float bias, const u32x4 (&qrow)[8], const u32x4 (&krow)[8],
                                             bf16_t* qdst, bf16_t* kdst, int dld, bf16_t* skrow) {
  float run = 0.f;
  unsigned kprev = 0;
#pragma unroll
  for (int tt = 0; tt < 64; ++tt) {
    constexpr int dummy = 0; (void)dummy;
    const int t = DIR ? (63 - tt) : tt;
    const float* gr = sga + t * 32 + DIR * 16;
    const f32x4 g0 = *(const f32x4*)gr, g1 = *(const f32x4*)(gr + 4), g2 = *(const f32x4*)(gr + 8), g3 = *(const f32x4*)(gr + 12);
    float xg = bias;
    xg += g0[0] * w[0] + g0[1] * w[1] + g0[2] * w[2] + g0[3] * w[3];
    xg += g1[0] * w[4] + g1[1] * w[5] + g1[2] * w[6] + g1[3] * w[7];
    xg += g2[0] * w[8] + g2[1] * w[9] + g2[2] * w[10] + g2[3] * w[11];
    xg += g3[0] * w[12] + g3[1] * w[13] + g3[2] * w[14] + g3[3] * w[15];
    const float ls = fminf(xg, 0.f) - __logf(1.0f + __expf(-fabsf(xg)));
    run += ls * (1.0f / 16.0f);
    const unsigned qw = qrow[t >> 3][(t >> 1) & 3], kw = krow[t >> 3][(t >> 1) & 3];
    const float qv = (t & 1) ? bfhi(qw) : bflo(qw), kv = (t & 1) ? bfhi(kw) : bflo(kw);
    const unsigned kin = cvt_pk(kv * __expf(-run), 0.f) & 0xffffu;
    qdst[(size_t)t * dld] = f2bf(qv * __expf(run) * 0.08838834764831845f);
    kdst[(size_t)t * dld] = (bf16_t)kin;
    if ((tt & 1) == 0) kprev = kin;
    else {
      const unsigned pr = DIR ? (kin | (kprev << 16)) : (kprev | (kin << 16));
      *(unsigned*)(skrow + (t & ~1)) = pr;
    }
  }
  return run;
}

__device__ void gla_g1_task(const Params& p, int l, int c, int h, unsigned char* smem) {
  bf16_t* Z = (bf16_t*)(p.ws + OFF_Z);
  bf16_t* Hb = (bf16_t*)(p.ws + OFF_H);
  const bf16_t* GVT = (const bf16_t*)(p.ws + OFF_GVT);
  const float* GA = (const float*)(p.ws + OFF_GA);
  float* DL = (float*)(p.ws + OFF_DL);
  bf16_t* ST = (bf16_t*)(p.ws + OFF_ST);
  const int tid = opaque_tid(), lane = tid & 63, wid = tid >> 6, x = lane & 15, quad = lane >> 4;
  const int dir = tid >> 7, d = tid & 127, row0 = c * 64;
  float* sga = (float*)smem;
  bf16_t* skot = (bf16_t*)(smem + 8192);
  float* sdl = (float*)(smem + 8192 + 36864);
  __syncthreads();
#pragma unroll
  for (int i = 0; i < 2; ++i) { const int id = tid + i * 256; *(f32x4*)(sga + id * 4) = *(const f32x4*)(GA + (size_t)row0 * 32 + id * 4); }
#pragma unroll
  for (int i = 0; i < 8; ++i) {
    const int id = tid + i * 256, which = id >> 10, t = (id >> 4) & 63, ch = id & 15;
    const u32x4 v = *(const u32x4*)(Z + (size_t)(row0 + t) * ZLD + (which ? ZGQ : ZGK) + h * 128 + ch * 8);
    bf16_t* dst = skot + (which * 128 + ch * 8) * 72 + t;
    dst[0 * 72] = (bf16_t)(v.x & 0xffff); dst[1 * 72] = (bf16_t)(v.x >> 16); dst[2 * 72] = (bf16_t)(v.y & 0xffff); dst[3 * 72] = (bf16_t)(v.y >> 16);
    dst[4 * 72] = (bf16_t)(v.z & 0xffff); dst[5 * 72] = (bf16_t)(v.z >> 16); dst[6 * 72] = (bf16_t)(v.w & 0xffff); dst[7 * 72] = (bf16_t)(v.w >> 16);
  }
  float w[16];
#pragma unroll
  for (int r = 0; r < 16; ++r) w[r] = p.w_decay[((size_t)(l * 2 + dir) * 16 + r) * 512 + h * 128 + d];
  const float bias = p.b_decay[(size_t)(l * 2 + dir) * 512 + h * 128 + d];
  __syncthreads();
  u32x4 qrow[8], krow[8];
#pragma unroll
  for (int i = 0; i < 8; ++i) { krow[i] = *(const u32x4*)(skot + (size_t)d * 72 + i * 8); qrow[i] = *(const u32x4*)(skot + (size_t)(128 + d) * 72 + i * 8); }
  asm volatile("s_waitcnt lgkmcnt(0)" ::: "memory");
  __syncthreads();
  bf16_t* qdst = dir ? (Hb + (size_t)row0 * D + h * 128 + d) : (Z + (size_t)row0 * ZLD + ZGQ + h * 128 + d);
  bf16_t* kdst = dir ? (Hb + (size_t)row0 * D + 512 + h * 128 + d) : (Z + (size_t)row0 * ZLD + ZGK + h * 128 + d);
  float run;
  if (dir == 0) run = gla_g1_scan<0>(sga, w, bias, qrow, krow, qdst, kdst, ZLD, skot + (size_t)d * 72);
  else run = gla_g1_scan<1>(sga, w, bias, qrow, krow, qdst, kdst, D, skot + (size_t)(128 + d) * 72);
  const float dlast = __expf(run);
  DL[((size_t)(dir * NCH + c) * 4 + h) * 128 + d] = dlast;
  sdl[dir * 128 + d] = dlast;
  __syncthreads();
  bf16x8 vb[4][2];
#pragma unroll
  for (int jt = 0; jt < 4; ++jt)
#pragma unroll
    for (int kk = 0; kk < 2; ++kk)
      vb[jt][kk] = *(const bf16x8*)(GVT + (size_t)(h * 256 + wid * 64 + jt * 16 + x) * R + row0 + kk * 32 + quad * 8);
#pragma unroll
  for (int dd = 0; dd < 2; ++dd) {
    bf16_t* dst = ST + st_index(dd, c, h);
#pragma unroll
    for (int it = 0; it < 8; ++it) {
      bf16x8 ka[2];
#pragma unroll
      for (int kk = 0; kk < 2; ++kk) ka[kk] = *(const bf16x8*)(skot + (dd * 128 + it * 16 + x) * 72 + kk * 32 + quad * 8);
      const f32x4 sc = *(const f32x4*)(sdl + dd * 128 + it * 16 + quad * 4);
#pragma unroll
      for (int jt = 0; jt < 4; ++jt) {
        f32x4 a = (f32x4){0.f, 0.f, 0.f, 0.f};
        a = mfma16(ka[0], vb[jt][0], a);
        a = mfma16(ka[1], vb[jt][1], a);
        a = a * sc;
        u32x2 wv; wv.x = cvt_pk(a[0], a[1]); wv.y = cvt_pk(a[2], a[3]);
        *(u32x2*)(dst + (size_t)(wid * 64 + jt * 16 + x) * 128 + it * 16 + quad * 4) = wv;
      }
    }
  }
}

constexpr int G2_TASKS = 2 * 4 * 32;
__device__ void gla_g2_task(const Params& p, int t) {
  bf16_t* ST = (bf16_t*)(p.ws + OFF_ST);
  const float* DL = (const float*)(p.ws + OFF_DL);
  const int dir = t >> 7, h = (t >> 5) & 3, slab = t & 31;
  const int e0 = (slab * 256 + opaque_tid()) * 4;
  const int dk = e0 & 127;
  f32x4 S = (f32x4){0.f, 0.f, 0.f, 0.f};
  constexpr int BATCH = 10;
  for (int s0 = 0; s0 < NCH; s0 += BATCH) {
    u32x2 kv[BATCH]; f32x4 dl[BATCH];
#pragma unroll
    for (int j = 0; j < BATCH; ++j) {
      const int s = s0 + j;
      const int c = dir ? (259 - s) : (s < 4 ? 256 + s : s - 4);
      kv[j] = *(const u32x2*)(ST + st_index(dir, c, h) + e0);
      dl[j] = *(const f32x4*)(DL + ((size_t)(dir * NCH + c) * 4 + h) * 128 + dk);
    }
#pragma unroll
    for (int j = 0; j < BATCH; ++j) {
      const int s = s0 + j;
      const int c = dir ? (259 - s) : (s < 4 ? 256 + s : s - 4);
      u32x2 w; w.x = cvt_pk(S[0], S[1]); w.y = cvt_pk(S[2], S[3]);
      *(u32x2*)(ST + st_index(dir, c, h) + e0) = w;
      S[0] = S[0] * dl[j][0] + bflo(kv[j].x); S[1] = S[1] * dl[j][1] + bfhi(kv[j].x);
      S[2] = S[2] * dl[j][2] + bflo(kv[j].y); S[3] = S[3] * dl[j][3] + bfhi(kv[j].y);
    }
  }
}

__device__ void gla_g3_task(const Params& p, int l, int c, int h) {
  bf16_t* Z = (bf16_t*)(p.ws + OFF_Z);
  const bf16_t* Hb = (const bf16_t*)(p.ws + OFF_H);
  const bf16_t* GVT = (const bf16_t*)(p.ws + OFF_GVT);
  const bf16_t* ST = (const bf16_t*)(p.ws + OFF_ST);
  const int tid = opaque_tid(), lane = tid & 63, wid = tid >> 6, x = lane & 15, quad = lane >> 4;
  const int row0 = c * 64, toki = wid * 16 + x;
  f32x4 o[16];
#pragma unroll
  for (int dt = 0; dt < 16; ++dt) o[dt] = (f32x4){0.f, 0.f, 0.f, 0.f};
  f32x4 atot[4];
#pragma unroll
  for (int t = 0; t < 4; ++t) atot[t] = (f32x4){0.f, 0.f, 0.f, 0.f};
#pragma unroll
  for (int dir = 0; dir < 2; ++dir) {
    const bf16_t* qbase = dir ? (Hb + (size_t)row0 * D + h * 128) : (Z + (size_t)row0 * ZLD + ZGQ + h * 128);
    const bf16_t* kbase = dir ? (Hb + (size_t)row0 * D + 512 + h * 128) : (Z + (size_t)row0 * ZLD + ZGK + h * 128);
    const int ld = dir ? D : ZLD;
    bf16x8 qb[4];
#pragma unroll
    for (int kk = 0; kk < 4; ++kk) qb[kk] = *(const bf16x8*)(qbase + (size_t)toki * ld + kk * 32 + quad * 8);
#pragma unroll
    for (int t = 0; t < 4; ++t) {
      f32x4 a = (f32x4){0.f, 0.f, 0.f, 0.f};
#pragma unroll
      for (int kk = 0; kk < 4; ++kk) {
        const bf16x8 kf = *(const bf16x8*)(kbase + (size_t)(t * 16 + x) * ld + kk * 32 + quad * 8);
        a = mfma16(kf, qb[kk], a);
      }
#pragma unroll
      for (int r = 0; r < 4; ++r) {
        const int tokj = t * 16 + quad * 4 + r;
        const bool keep = dir ? (tokj >= toki) : (tokj <= toki);
        atot[t][r] += keep ? a[r] : 0.f;
      }
    }
    const bf16_t* S = ST + st_index(dir, c, h);
#pragma unroll
    for (int dt = 0; dt < 16; ++dt) {
#pragma unroll
      for (int kk = 0; kk < 4; ++kk) {
        const bf16x8 sf = *(const bf16x8*)(S + (size_t)(dt * 16 + x) * 128 + kk * 32 + quad * 8);
        o[dt] = mfma16(sf, qb[kk], o[dt]);
      }
      if ((dt & 3) == 3) __builtin_amdgcn_sched_barrier(0);
    }
  }
  bf16x8 pb[2];
#pragma unroll
  for (int hh = 0; hh < 2; ++hh) {
    u32x4 w;
    w.x = cvt_pk(atot[2 * hh][0], atot[2 * hh][1]); w.y = cvt_pk(atot[2 * hh][2], atot[2 * hh][3]);
    w.z = cvt_pk(atot[2 * hh + 1][0], atot[2 * hh + 1][1]); w.w = cvt_pk(atot[2 * hh + 1][2], atot[2 * hh + 1][3]);
    pb[hh] = __builtin_bit_cast(bf16x8, w);
  }
#pragma unroll
  for (int dt = 0; dt < 16; ++dt) {
    const bf16_t* vr = GVT + (size_t)(h * 256 + dt * 16 + x) * R + row0 + quad * 4;
#pragma unroll
    for (int hh = 0; hh < 2; ++hh) {
      const u32x2 v0 = *(const u32x2*)(vr + (2 * hh) * 16), v1 = *(const u32x2*)(vr + (2 * hh + 1) * 16);
      u32x4 w; w.x = v0.x; w.y = v0.y; w.z = v1.x; w.w = v1.y;
      o[dt] = mfma16(__builtin_bit_cast(bf16x8, w), pb[hh], o[dt]);
    }
    if ((dt & 3) == 3) __builtin_amdgcn_sched_barrier(0);
  }
  float ss = 0.f;
#pragma unroll
  for (int dt = 0; dt < 16; ++dt) ss += o[dt][0] * o[dt][0] + o[dt][1] * o[dt][1] + o[dt][2] * o[dt][2] + o[dt][3] * o[dt][3];
  ss += __shfl_xor(ss, 16); ss += __shfl_xor(ss, 32);
  const float rstd = rsqrtf(ss * (1.0f / 256.0f) + EPS);
  bf16_t* grp = Z + (size_t)(row0 + toki) * ZLD + ZGR + h * 256 + quad * 4;
  const float* gain = p.gla_gain + l * 256 + quad * 4;
#pragma unroll
  for (int dt = 0; dt < 16; ++dt) {
    const f32x4 gn = *(const f32x4*)(gain + dt * 16);
    const u32x2 gg = *(const u32x2*)(grp + dt * 16);
    const float y0 = o[dt][0] * rstd * gn[0] * siluf_(bflo(gg.x)), y1 = o[dt][1] * rstd * gn[1] * siluf_(bfhi(gg.x));
    const float y2 = o[dt][2] * rstd * gn[2] * siluf_(bflo(gg.y)), y3 = o[dt][3] * rstd * gn[3] * siluf_(bfhi(gg.y));
    u32x2 w; w.x = cvt_pk(y0, y1); w.y = cvt_pk(y2, y3);
    *(u32x2*)(grp + dt * 16) = w;
  }
}

#ifndef DIS
#define DIS 0
#endif
constexpr int LDS_BYTES = 65536;
constexpr int PH_PER_LAYER = 10;
constexpr int NPHASES = 1 + DEPTH * PH_PER_LAYER;

__global__ void __launch_bounds__(256, 2) mk(Params p, int ph_lo, int ph_hi, int coop) {
  __shared__ __attribute__((aligned(16))) unsigned char smem[LDS_BYTES];
  cg::grid_group grid = cg::this_grid();
  const int G = gridDim.x, b = blockIdx.x;
  for (int ph = ph_lo; ph < ph_hi; ++ph) {
    if (coop && ph > ph_lo) grid.sync();
    if (ph == 0) {
      for (int t = b; t < MOD_TASKS + 16 + CV_TOTAL; t += G) {
        if (t < MOD_TASKS) { if (!(DIS & 1)) mod_task(p, t, smem); }
        else if (t < MOD_TASKS + 16) rope_task(p, t - MOD_TASKS);
        else { if (!(DIS & 2)) convert_task(p, 0, t - MOD_TASKS - 16, smem); }
      }
      continue;
    }
    const int l = (ph - 1) / PH_PER_LAYER, s = (ph - 1) % PH_PER_LAYER;
    const bool last = l == DEPTH - 1;
    const float* xlat = l == 0 ? p.x : p.out;
    const float* xctx = l == 0 ? p.ctx : (const float*)(p.ws + OFF_XC);
    const int ntm = last ? (NTOK / 128) : (R / 128);
    switch (s) {
      case 0: {
        const int ncv = l > 0 ? CV_TOTAL : 0;
        for (int t = b; t < R / 16 + ncv; t += G) {
          if (t < R / 16) norm_task(p, l, t, 0, xlat, xctx);
          else { if (!(DIS & 2)) convert_task(p, l, t - R / 16, smem); }
        }
      } break;
      case 1: if (!(DIS & 4)) phase_gemm_in(p, l, smem); break;
      case 2: {
        const int nattn = (last ? NTOK / 128 : R / 128) * 16;
        for (int t = b; t < NCH * 4 + nattn; t += G) {
          if (t < NCH * 4) { if (!(DIS & 8)) gla_g1_task(p, l, t >> 2, t & 3, smem); }
          else { const int a = t - NCH * 4; if (!(DIS & 16)) attn_task(p, l, a >> 4, a & 15, smem); }
        }
      } break;
      case 3: for (int t = b; t < G2_TASKS; t += G) { if (!(DIS & 32)) gla_g2_task(p, t); } break;
      case 4: { const int nc = last ? 256 : NCH; for (int t = b; t < nc * 4; t += G) { if (!(DIS & 64)) gla_g3_task(p, l, t >> 2, t & 3); } } break;
      case 5: if (!(DIS & 128)) phase_gemm<0>(p, l, ntm, nullptr, 0, nullptr, D, 8, 0, nullptr, nullptr, smem); break;
      case 6: if (!(DIS & 256)) phase_gemm<1>(p, l, ntm, (const bf16_t*)(p.ws + OFF_H), D, (const bf16_t*)(p.ws + OFF_WO), D, 8, 2, xlat, xctx, smem); break;
      case 7: for (int t = b; t < ntm * 8; t += G) norm_task(p, l, t, 1, p.out, (const float*)(p.ws + OFF_XC)); break;
      case 8: if (!(DIS & 512)) phase_gemm<2>(p, l, ntm, (const bf16_t*)(p.ws + OFF_H), D, (const bf16_t*)(p.ws + OFF_WF1), D, 32, 0, nullptr, nullptr, smem); break;
      case 9: if (!(DIS & 256)) phase_gemm<1>(p, l, ntm, (const bf16_t*)(p.ws + OFF_Z), DFF, (const bf16_t*)(p.ws + OFF_WF2), DFF, 8, 5, p.out, (const float*)(p.ws + OFF_XC), smem); break;
    }
  }
}

#ifndef MULTI_LAUNCH
#define MULTI_LAUNCH 0
#endif

extern "C" void kernel_launch(void* const* d_in, const int* in_sizes, int n_in, void* d_out, int out_size,
                              void* d_ws, size_t ws_size, hipStream_t stream) {
  static int grid_blocks = 0;
  if (!grid_blocks) {
    int dev = 0, cus = 0, per_cu = 0;
    (void)hipGetDevice(&dev);
    (void)hipDeviceGetAttribute(&cus, hipDeviceAttributeMultiprocessorCount, dev);
    (void)hipOccupancyMaxActiveBlocksPerMultiprocessor(&per_cu, mk, 256, 0);
    if (per_cu > 2) per_cu = 2;
    if (per_cu < 1) per_cu = 1;
    grid_blocks = cus * per_cu;
  }
  if (ws_size < WS_NEED) { fprintf(stderr, "workspace too small: %zu < %zu\n", ws_size, (size_t)WS_NEED); return; }
  Params p{};
  const float** f = (const float**)&p;
  for (int i = 0; i < 20; ++i) f[i] = (const float*)d_in[i];
  p.out = (float*)d_out;
  p.ws = (unsigned char*)d_ws;
#if MULTI_LAUNCH
  for (int ph = 0; ph < NPHASES; ++ph) {
    int lo = ph, hi = ph + 1, coop = 0;
    hipLaunchKernelGGL(mk, dim3(grid_blocks), dim3(256), 0, stream, p, lo, hi, coop);
  }
#else
  int lo = 0, hi = NPHASES, coop = 1;
  void* args[] = {&p, &lo, &hi, &coop};
  hipError_t e = hipLaunchCooperativeKernel((void*)mk, dim3(grid_blocks), dim3(256), args, 0, stream);
  if (e != hipSuccess) fprintf(stderr, "cooperative launch failed: %s (grid %d)\n", hipGetErrorString(e), grid_blocks);
#endif
}
```

```cpp
#include <hip/hip_runtime.h>
#include <hip/hip_cooperative_groups.h>
#include <cstdio>
#include <cstdint>
namespace cg = cooperative_groups;

typedef unsigned short bf16_t;
typedef short bf16x8 __attribute__((ext_vector_type(8)));
typedef float f32x4 __attribute__((ext_vector_type(4)));
typedef unsigned u32x2 __attribute__((ext_vector_type(2)));
typedef unsigned u32x4 __attribute__((ext_vector_type(4)));

constexpr int NTOK = 16384, LCTX = 256, R = NTOK + LCTX, D = 1024, DFF = 4096, DEPTH = 4;
constexpr int D_IN_SRC = 6688;
constexpr int ZLD = 5376;
constexpr int ZQ = 0, ZK = 1024, ZGQ = 1280, ZGK = 1792, ZGR = 2304, ZGA = 3328, ZGB = 4352;
constexpr int WIN_ROWS = 6784;
constexpr int NCH = R / 64;
constexpr float EPS = 1e-6f;
constexpr float LOG2E = 1.4426950408889634f;

constexpr size_t al256(size_t x) { return (x + 255) & ~(size_t)255; }
constexpr size_t OFF_WIN = 0;
constexpr size_t OFF_WBA = OFF_WIN + al256((size_t)WIN_ROWS * D * 2);
constexpr size_t OFF_WBG = OFF_WBA + al256((size_t)D * D * 2);
constexpr size_t OFF_WO  = OFF_WBG + al256((size_t)D * D * 2);
constexpr size_t OFF_WF1 = OFF_WO  + al256((size_t)D * D * 2);
constexpr size_t OFF_WF2 = OFF_WF1 + al256((size_t)DFF * D * 2);
constexpr size_t OFF_H   = OFF_WF2 + al256((size_t)DFF * D * 2);
constexpr size_t OFF_Z   = OFF_H   + al256((size_t)R * D * 2);
constexpr size_t OFF_VT  = OFF_Z   + al256((size_t)R * ZLD * 2);
constexpr size_t OFF_GVT = OFF_VT  + al256((size_t)256 * R * 2);
constexpr size_t OFF_ST  = OFF_GVT + al256((size_t)1024 * R * 2);
constexpr size_t OFF_GA  = OFF_ST  + al256((size_t)2 * NCH * 4 * 256 * 128 * 2);
constexpr size_t OFF_DL  = OFF_GA  + al256((size_t)R * 32 * 4);
constexpr size_t OFF_MOD = OFF_DL  + al256((size_t)2 * NCH * 4 * 128 * 4);
constexpr size_t OFF_XC  = OFF_MOD + al256((size_t)DEPTH * 2 * 6 * D * 4);
constexpr size_t OFF_ROPE = OFF_XC + al256((size_t)LCTX * D * 4);
constexpr size_t OFF_BAR = OFF_ROPE + al256((size_t)256 * 16 * 8);
constexpr size_t OFF_MODP = OFF_BAR + al256((size_t)3456 * 4);
constexpr size_t OFF_Y32 = OFF_MODP;
constexpr size_t WS_NEED = OFF_Y32 + al256((size_t)LCTX * D * 4);

struct Params {
  const float *x, *c, *ctx, *c_ctx, *w_mod, *b_mod, *g_norm1, *w_in, *q_gain, *k_gain, *sink, *w_decay, *b_decay,
      *gla_gain, *w_ba, *w_bg, *w_out, *g_norm2, *w_ff1, *w_ff2;
  float* out;
  unsigned char* ws;
};

#define LAS __attribute__((address_space(3)))
__device__ __forceinline__ int opaque_tid() { int t = threadIdx.x; asm volatile("" : "+v"(t)); return t; }
__device__ __forceinline__ float bf2f(unsigned h) { return __uint_as_float(h << 16); }
__device__ __forceinline__ unsigned cvt_pk(float lo, float hi) { unsigned r; asm("v_cvt_pk_bf16_f32 %0, %1, %2" : "=v"(r) : "v"(lo), "v"(hi)); return r; }
__device__ __forceinline__ bf16_t f2bf(float f) { return (bf16_t)(cvt_pk(f, 0.f) & 0xffffu); }
__device__ __forceinline__ float bflo(unsigned u) { return __uint_as_float(u << 16); }
__device__ __forceinline__ float bfhi(unsigned u) { return __uint_as_float(u & 0xffff0000u); }
__device__ __forceinline__ float sigmoidf_(float x) { return 1.0f / (1.0f + __expf(-x)); }
__device__ __forceinline__ float siluf_(float x) { return x / (1.0f + __expf(-x)); }
__device__ __forceinline__ f32x4 mfma16(bf16x8 a, bf16x8 b, f32x4 c) { return __builtin_amdgcn_mfma_f32_16x16x32_bf16(a, b, c, 0, 0, 0); }

template <bool SWAP>
__device__ __forceinline__ void gemm_step(const unsigned char* __restrict__ rd, unsigned char* __restrict__ wr, bool refill,
                                          const bf16_t* __restrict__ ga, const bf16_t* __restrict__ gb, size_t a64, size_t b64,
                                          int aoff, int boff, f32x4 (&acc)[4][4]) {
  if (refill) {
    __builtin_amdgcn_global_load_lds((const unsigned*)(ga), (LAS unsigned*)(wr), 16, 0, 0);
    __builtin_amdgcn_global_load_lds((const unsigned*)(ga + a64), (LAS unsigned*)(wr + 4096), 16, 0, 0);
    __builtin_amdgcn_global_load_lds((const unsigned*)(gb), (LAS unsigned*)(wr + 8192), 16, 0, 0);
    __builtin_amdgcn_global_load_lds((const unsigned*)(gb + b64), (LAS unsigned*)(wr + 12288), 16, 0, 0);
  }
  bf16x8 af[4], bfv[4];
  const unsigned ra = (unsigned)(size_t)(const LAS unsigned char*)rd + (unsigned)aoff, rb = (unsigned)(size_t)(const LAS unsigned char*)rd + (unsigned)boff;
  asm volatile("ds_read_b128 %0, %1" : "=v"(af[0]) : "v"(ra));
  asm volatile("ds_read_b128 %0, %1" : "=v"(bfv[0]) : "v"(rb));
  asm volatile("ds_read_b128 %0, %1 offset:1024" : "=v"(af[1]) : "v"(ra));
  asm volatile("ds_read_b128 %0, %1 offset:1024" : "=v"(bfv[1]) : "v"(rb));
  asm volatile("ds_read_b128 %0, %1 offset:2048" : "=v"(af[2]) : "v"(ra));
  asm volatile("ds_read_b128 %0, %1 offset:2048" : "=v"(bfv[2]) : "v"(rb));
  asm volatile("ds_read_b128 %0, %1 offset:3072" : "=v"(af[3]) : "v"(ra));
  asm volatile("ds_read_b128 %0, %1 offset:3072" : "=v"(bfv[3]) : "v"(rb));
  asm volatile("s_waitcnt lgkmcnt(0)" : "+v"(af[0]), "+v"(af[1]), "+v"(af[2]), "+v"(af[3]), "+v"(bfv[0]), "+v"(bfv[1]), "+v"(bfv[2]), "+v"(bfv[3]));
#pragma unroll
  for (int mi = 0; mi < 4; ++mi)
#pragma unroll
    for (int ni = 0; ni < 4; ++ni)
      acc[mi][ni] = SWAP ? mfma16(bfv[ni], af[mi], acc[mi][ni]) : mfma16(af[mi], bfv[ni], acc[mi][ni]);
}

struct GNext { const bf16_t* A; const bf16_t* B; int lda, ldb; bool has; };
template <bool SWAP>
__device__ __forceinline__ void gemm_core(const bf16_t* __restrict__ A, int lda, const bf16_t* __restrict__ B, int ldb, int K,
                                          f32x4 (&acc)[4][4], unsigned char* smem, bool prefetched, const GNext nx) {
  const int tid = opaque_tid(), lane = tid & 63, wid = tid >> 6, wr = wid >> 1, wc = wid & 1, x = lane & 15, quad = lane >> 4;
  const int nk = K >> 5;
  const int lrow = tid >> 2, gch = (tid & 3) ^ ((0x78 >> (2 * ((tid >> 4) & 3))) & 3);
  const bf16_t* ga = A + (size_t)lrow * lda + gch * 8;
  const bf16_t* gb = B + (size_t)lrow * ldb + gch * 8;
  const size_t a64 = (size_t)64 * lda, b64 = (size_t)64 * ldb;
  unsigned char* sdst = smem + tid * 16;
#define GC_PAIR(k_) do { unsigned char* _d0 = sdst + ((k_) & 3) * 16384; unsigned char* _d1 = sdst + (((k_) + 1) & 3) * 16384; \
    const bf16_t* _pa = ga + (k_) * 32; const bf16_t* _pb = gb + (k_) * 32; \
    __builtin_amdgcn_global_load_lds((const unsigned*)(_pa), (LAS unsigned*)(_d0), 16, 0, 0); \
    __builtin_amdgcn_global_load_lds((const unsigned*)(_pa + 32), (LAS unsigned*)(_d1), 16, 0, 0); \
    __builtin_amdgcn_global_load_lds((const unsigned*)(_pa + a64), (LAS unsigned*)(_d0 + 4096), 16, 0, 0); \
    __builtin_amdgcn_global_load_lds((const unsigned*)(_pa + a64 + 32), (LAS unsigned*)(_d1 + 4096), 16, 0, 0); \
    __builtin_amdgcn_global_load_lds((const unsigned*)(_pb), (LAS unsigned*)(_d0 + 8192), 16, 0, 0); \
    __builtin_amdgcn_global_load_lds((const unsigned*)(_pb + 32), (LAS unsigned*)(_d1 + 8192), 16, 0, 0); \
    __builtin_amdgcn_global_load_lds((const unsigned*)(_pb + b64), (LAS unsigned*)(_d0 + 12288), 16, 0, 0); \
    __builtin_amdgcn_global_load_lds((const unsigned*)(_pb + b64 + 32), (LAS unsigned*)(_d1 + 12288), 16, 0, 0); } while (0)
  if (!prefetched) {
    __syncthreads();
    GC_PAIR(0);
  }
  const int rsw = (quad ^ ((0x78 >> (2 * ((x >> 2) & 3))) & 3)) << 4;
  const int aoff = (wr * 64 + x) * 64 + rsw, boff = 8192 + (wc * 64 + x) * 64 + rsw;
  for (int kt = 0; kt < nk; kt += 2) {
    asm volatile("s_waitcnt vmcnt(0)" ::: "memory");
    __builtin_amdgcn_s_barrier();
    asm volatile("" ::: "memory");
    if (kt + 2 < nk) GC_PAIR(kt + 2);
    else if (nx.has) {
      const bf16_t* na = nx.A + (size_t)lrow * nx.lda + gch * 8;
      const bf16_t* nb = nx.B + (size_t)lrow * nx.ldb + gch * 8;
      const size_t na64 = (size_t)64 * nx.lda, nb64 = (size_t)64 * nx.ldb;
      unsigned char* d0 = sdst; unsigned char* d1 = sdst + 16384;
      __builtin_amdgcn_global_load_lds((const unsigned*)(na), (LAS unsigned*)(d0), 16, 0, 0);
      __builtin_amdgcn_global_load_lds((const unsigned*)(na + 32), (LAS unsigned*)(d1), 16, 0, 0);
      __builtin_amdgcn_global_load_lds((const unsigned*)(na + na64), (LAS unsigned*)(d0 + 4096), 16, 0, 0);
      __builtin_amdgcn_global_load_lds((const unsigned*)(na + na64 + 32), (LAS unsigned*)(d1 + 4096), 16, 0, 0);
      __builtin_amdgcn_global_load_lds((const unsigned*)(nb), (LAS unsigned*)(d0 + 8192), 16, 0, 0);
      __builtin_amdgcn_global_load_lds((const unsigned*)(nb + 32), (LAS unsigned*)(d1 + 8192), 16, 0, 0);
      __builtin_amdgcn_global_load_lds((const unsigned*)(nb + nb64), (LAS unsigned*)(d0 + 12288), 16, 0, 0);
      __builtin_amdgcn_global_load_lds((const unsigned*)(nb + nb64 + 32), (LAS unsigned*)(d1 + 12288), 16, 0, 0);
    }
    gemm_step<SWAP>(smem + (kt & 3) * 16384, sdst, false, ga, gb, a64, b64, aoff, boff, acc);
    asm volatile("" ::: "memory");
    gemm_step<SWAP>(smem + ((kt + 1) & 3) * 16384, sdst, false, ga, gb, a64, b64, aoff, boff, acc);
    asm volatile("" ::: "memory");
  }
#undef GC_PAIR
}

__device__ __forceinline__ void zero_acc(f32x4 (&acc)[4][4]) {
#pragma unroll
  for (int i = 0; i < 4; ++i)
#pragma unroll
    for (int j = 0; j < 4; ++j) acc[i][j] = (f32x4){0.f, 0.f, 0.f, 0.f};
}

__device__ __forceinline__ void store_tile_bf16(const u32x2 (&v)[4][4], bf16_t* gbase, size_t ld, unsigned char* smem, int wid, int lane, unsigned lds_ofs = 32768u) {
  const int x = lane & 15, quad = lane >> 4;
  const unsigned sw = (unsigned)(size_t)(const LAS unsigned char*)smem + lds_ofs + (unsigned)wid * 4608u;
  const unsigned wa = sw + (unsigned)(x * 144 + quad * 8);
  const unsigned rr = sw + (unsigned)((lane >> 3) * 144 + (lane & 7) * 16);
  __builtin_amdgcn_s_barrier();
  asm volatile("" ::: "memory");
#pragma unroll
  for (int half = 0; half < 2; ++half) {
    if (half == 1) asm volatile("s_waitcnt lgkmcnt(0)" ::: "memory");
#pragma unroll
    for (int m2 = 0; m2 < 2; ++m2) {
      asm volatile("ds_write_b64 %0, %1" :: "v"(wa + m2 * 2304), "v"(v[2 * half + m2][0]) : "memory");
      asm volatile("ds_write_b64 %0, %1 offset:32" :: "v"(wa + m2 * 2304), "v"(v[2 * half + m2][1]) : "memory");
      asm volatile("ds_write_b64 %0, %1 offset:64" :: "v"(wa + m2 * 2304), "v"(v[2 * half + m2][2]) : "memory");
      asm volatile("ds_write_b64 %0, %1 offset:96" :: "v"(wa + m2 * 2304), "v"(v[2 * half + m2][3]) : "memory");
    }
    u32x4 o0, o1, o2, o3;
    asm volatile("ds_read_b128 %0, %1" : "=v"(o0) : "v"(rr) : "memory");
    asm volatile("ds_read_b128 %0, %1 offset:1152" : "=v"(o1) : "v"(rr) : "memory");
    asm volatile("ds_read_b128 %0, %1 offset:2304" : "=v"(o2) : "v"(rr) : "memory");
    asm volatile("ds_read_b128 %0, %1 offset:3456" : "=v"(o3) : "v"(rr) : "memory");
    asm volatile("s_waitcnt lgkmcnt(0)" : "+v"(o0), "+v"(o1), "+v"(o2), "+v"(o3));
    bf16_t* g = gbase + (size_t)(half * 32 + (lane >> 3)) * ld + (lane & 7) * 8;
    *(u32x4*)(g) = o0;
    *(u32x4*)(g + 8 * ld) = o1;
    *(u32x4*)(g + 16 * ld) = o2;
    *(u32x4*)(g + 24 * ld) = o3;
  }
}

__device__ __forceinline__ void resid_tile_f32(const f32x4 (&upd)[4][4], const float* src, float* dst, size_t ld, unsigned char* smem, int wid, int lane) {
  const int x = lane & 15, quad = lane >> 4;
  const unsigned sw = (unsigned)(size_t)(const LAS unsigned char*)smem + 32768u + (unsigned)wid * 4608u;
  const unsigned wa = sw + (unsigned)(x * 272 + quad * 16);
  const unsigned rr = sw + (unsigned)((lane >> 4) * 272 + (lane & 15) * 16);
  __builtin_amdgcn_s_barrier();
  asm volatile("" ::: "memory");
#pragma unroll
  for (int mi = 0; mi < 4; ++mi) {
    if (mi > 0) asm volatile("s_waitcnt lgkmcnt(0)" ::: "memory");
    asm volatile("ds_write_b128 %0, %1" :: "v"(wa), "v"(upd[mi][0]) : "memory");
    asm volatile("ds_write_b128 %0, %1 offset:64" :: "v"(wa), "v"(upd[mi][1]) : "memory");
    asm volatile("ds_write_b128 %0, %1 offset:128" :: "v"(wa), "v"(upd[mi][2]) : "memory");
    asm volatile("ds_write_b128 %0, %1 offset:192" :: "v"(wa), "v"(upd[mi][3]) : "memory");
    f32x4 o0, o1, o2, o3;
    asm volatile("ds_read_b128 %0, %1" : "=v"(o0) : "v"(rr) : "memory");
    asm volatile("ds_read_b128 %0, %1 offset:1088" : "=v"(o1) : "v"(rr) : "memory");
    asm volatile("ds_read_b128 %0, %1 offset:2176" : "=v"(o2) : "v"(rr) : "memory");
    asm volatile("ds_read_b128 %0, %1 offset:3264" : "=v"(o3) : "v"(rr) : "memory");
    const size_t go = (size_t)(mi * 16 + (lane >> 4)) * ld + (lane & 15) * 4;
    const f32x4 x0 = *(const f32x4*)(src + go), x1 = *(const f32x4*)(src + go + 4 * ld), x2 = *(const f32x4*)(src + go + 8 * ld), x3 = *(const f32x4*)(src + go + 12 * ld);
    asm volatile("s_waitcnt lgkmcnt(0)" : "+v"(o0), "+v"(o1), "+v"(o2), "+v"(o3));
    *(f32x4*)(dst + go) = x0 + o0;
    *(f32x4*)(dst + go + 4 * ld) = x1 + o1;
    *(f32x4*)(dst + go + 8 * ld) = x2 + o2;
    *(f32x4*)(dst + go + 12 * ld) = x3 + o3;
  }
}

__device__ __forceinline__ int gemm_bid() { const int b = blockIdx.x; return (gridDim.x == 512) ? ((b & 63) * 8 + (b >> 6)) : b; }
__device__ __forceinline__ void tile_map(int t, int ntm, int ntn, int& tm, int& tn) {
  const int per = 8 * ntn, grp = t / per, rem = t - grp * per;
  const int left = ntm - grp * 8, gsz = left < 8 ? left : 8;
  const int nblk = (gsz == 8) ? (ntn >> 3) * 64 : 0;
  if (rem < nblk) { const int cb = rem >> 6, r64 = rem & 63; tm = grp * 8 + (r64 >> 3); tn = cb * 8 + (r64 & 7); }
  else { const int r2 = rem - nblk; tm = grp * 8 + r2 % gsz; tn = (nblk >> 3) + r2 / gsz; }
}

__device__ void phase_gemm_in(const Params& p, int l, unsigned char* smem) {
  const bf16_t* H = (const bf16_t*)(p.ws + OFF_H);
  const bf16_t* W = (const bf16_t*)(p.ws + OFF_WIN);
  bf16_t* Z = (bf16_t*)(p.ws + OFF_Z);
  bf16_t* VT = (bf16_t*)(p.ws + OFF_VT);
  bf16_t* GVT = (bf16_t*)(p.ws + OFF_GVT);
  float* GA = (float*)(p.ws + OFF_GA);
  const float* ROPE = (const float*)(p.ws + OFF_ROPE);
  const int tid = opaque_tid(), lane = tid & 63, wid = tid >> 6, wr = wid >> 1, wc = wid & 1, x = lane & 15, quad = lane >> 4;
  constexpr int NTN = 53, NTM = R / 128;
  for (int t = gemm_bid(); t < NTN * NTM; t += gridDim.x) {
    int tm, tn; tile_map(t, NTM, NTN, tm, tn);
    const int row0 = tm * 128;
    f32x4 acc[4][4];
    zero_acc(acc);
    const bf16_t* Ap = H + (size_t)row0 * D;
    const bf16_t* Bp = W + (size_t)tn * 128 * D;
    const bool pref = t != gemm_bid();
    GNext nx{nullptr, nullptr, D, D, false};
    { const int t2 = t + gridDim.x; if (t2 < NTN * NTM) { int tm2, tn2; tile_map(t2, NTM, NTN, tm2, tn2); nx.A = H + (size_t)tm2 * 128 * D; nx.B = W + (size_t)tn2 * 128 * D; nx.has = true; } }
    if (tn >= 42 && tn < 52) {
      gemm_core<false>(Ap, D, Bp, D, D, acc, smem, pref, nx);
      u32x2 pk[4][4];
#pragma unroll
      for (int ni = 0; ni < 4; ++ni)
#pragma unroll
        for (int mi = 0; mi < 4; ++mi) { pk[ni][mi].x = cvt_pk(acc[mi][ni][0], acc[mi][ni][1]); pk[ni][mi].y = cvt_pk(acc[mi][ni][2], acc[mi][ni][3]); }
      const int n0 = (tn - 42) * 128 + wc * 64;
      bf16_t* tb = (n0 < 256) ? (VT + (size_t)n0 * R) : (GVT + (size_t)(n0 - 256) * R);
      store_tile_bf16(pk, tb + row0 + wr * 64, R, smem, wid, lane);
    } else {
      gemm_core<true>(Ap, D, Bp, D, D, acc, smem, pref, nx);
      if (tn == 52) {
        if (wc == 0) {
#pragma unroll
          for (int mi = 0; mi < 4; ++mi) {
            const int row = row0 + wr * 64 + mi * 16 + x;
#pragma unroll
            for (int ni = 0; ni < 2; ++ni) *(f32x4*)(GA + (size_t)row * 32 + ni * 16 + quad * 4) = acc[mi][ni];
          }
        }
      } else if (tn < 10) {
        const bool isq = tn < 8;
        const float* gain = (isq ? p.q_gain : p.k_gain) + l * 64;
        f32x4 gv[4];
#pragma unroll
        for (int ni = 0; ni < 4; ++ni) gv[ni] = *(const f32x4*)(gain + ni * 16 + quad * 4);
        const float post = isq ? (0.125f * LOG2E) : 1.0f;
        u32x2 pk[4][4];
#pragma unroll
        for (int mi = 0; mi < 4; ++mi) {
          const int row = row0 + wr * 64 + mi * 16 + x;
          float ss = 0.f;
#pragma unroll
          for (int ni = 0; ni < 4; ++ni)
#pragma unroll
            for (int r = 0; r < 4; ++r) ss += acc[mi][ni][r] * acc[mi][ni][r];
          ss += __shfl_xor(ss, 16); ss += __shfl_xor(ss, 32);
          const float rstd = rsqrtf(ss * (1.0f / 64.0f) + EPS);
          f32x4 v[4];
#pragma unroll
          for (int ni = 0; ni < 4; ++ni) v[ni] = acc[mi][ni] * rstd * gv[ni];
          if (row < NTOK) {
            const int prow = row >> 6, pcol = row & 63;
            const float* t0 = ROPE + ((size_t)prow * 16 + quad * 4) * 2;
            const float* t1 = ROPE + ((size_t)pcol * 16 + quad * 4) * 2;
            const f32x4 a0 = *(const f32x4*)t0, a1 = *(const f32x4*)(t0 + 4), b0 = *(const f32x4*)t1, b1 = *(const f32x4*)(t1 + 4);
            const float cr[4] = {a0[0], a0[2], a1[0], a1[2]}, sr[4] = {a0[1], a0[3], a1[1], a1[3]};
            const float cc[4] = {b0[0], b0[2], b1[0], b1[2]}, sc[4] = {b0[1], b0[3], b1[1], b1[3]};
#pragma unroll
            for (int r = 0; r < 4; ++r) {
              const float x1 = v[0][r], x2 = v[1][r];
              v[0][r] = x1 * cr[r] - x2 * sr[r]; v[1][r] = x2 * cr[r] + x1 * sr[r];
              const float y1 = v[2][r], y2 = v[3][r];
              v[2][r] = y1 * cc[r] - y2 * sc[r]; v[3][r] = y2 * cc[r] + y1 * sc[r];
            }
          }
#pragma unroll
          for (int ni = 0; ni < 4; ++ni) { pk[mi][ni].x = cvt_pk(v[ni][0] * post, v[ni][1] * post); pk[mi][ni].y = cvt_pk(v[ni][2] * post, v[ni][3] * post); }
        }
        store_tile_bf16(pk, Z + (size_t)(row0 + wr * 64) * ZLD + tn * 128 + wc * 64, ZLD, smem, wid, lane);
      } else {
        u32x2 pk[4][4];
#pragma unroll
        for (int mi = 0; mi < 4; ++mi)
#pragma unroll
          for (int ni = 0; ni < 4; ++ni) { pk[mi][ni].x = cvt_pk(acc[mi][ni][0], acc[mi][ni][1]); pk[mi][ni].y = cvt_pk(acc[mi][ni][2], acc[mi][ni][3]); }
        store_tile_bf16(pk, Z + (size_t)(row0 + wr * 64) * ZLD + tn * 128 + wc * 64, ZLD, smem, wid, lane);
      }
    }
  }
}

template <int MODE>
__device__ void phase_gemm(const Params& p, int l, int ntm, const bf16_t* A, int lda, const bf16_t* W, int K, int ntn,
                           int gate_idx, const float* xsrc_lat, const float* xsrc_ctx, unsigned char* smem) {
  const int tid = opaque_tid(), lane = tid & 63, wid = tid >> 6, wr = wid >> 1, wc = wid & 1, x = lane & 15, quad = lane >> 4;
  bf16_t* Z = (bf16_t*)(p.ws + OFF_Z);
  bf16_t* Hb = (bf16_t*)(p.ws + OFF_H);
  float* XC = (float*)(p.ws + OFF_XC);
  const float* MOD = (const float*)(p.ws + OFF_MOD);
  const int KS = (MODE == 1 && ntm > NTOK / 128) ? (K == D ? 4 : 8) : 1;
  const int ntm_full = (KS > 1) ? NTOK / 128 : ntm;
  const int nfull = ntm_full * ntn, nunits = (KS > 1) ? 16 * KS : 0;
  auto decode = [&](int tt, int& row0_, int& col0_, int& kofs_, int& klen_, bool& split_) {
    int tm, tn; kofs_ = 0; klen_ = K; split_ = false;
    if (tt < nfull) tile_map(tt, ntm_full, ntn, tm, tn);
    else { const int u = tt - nfull, ks = u >> 4, r = u & 15; tm = NTOK / 128 + (r & 1); tn = r >> 1; klen_ = K / KS; kofs_ = ks * klen_; split_ = true; }
    row0_ = tm * 128; col0_ = tn * 128;
  };
  for (int t = gemm_bid(); t < nfull + nunits; t += gridDim.x) {
    int row0, col0, kofs, klen; bool split;
    decode(t, row0, col0, kofs, klen, split);
    const bool pref = t != gemm_bid();
    GNext nx{nullptr, nullptr, 0, 0, false};
    { const int t2 = t + gridDim.x;
      if (t2 < nfull + nunits) {
        int r2, c2, ko2, kl2; bool sp2; decode(t2, r2, c2, ko2, kl2, sp2);
        if (MODE == 0) { nx.A = Z + (size_t)r2 * ZLD + ZQ; nx.lda = ZLD; nx.B = (const bf16_t*)(p.ws + OFF_WBA) + (size_t)c2 * D; nx.ldb = D; }
        else { nx.A = A + (size_t)r2 * lda + ko2; nx.lda = lda; nx.B = W + (size_t)c2 * K + ko2; nx.ldb = K; }
        nx.has = !(MODE == 1 && K == D && sp2);
      } }
    f32x4 acc[4][4];
    zero_acc(acc);
    if (MODE == 0) {
      { const GNext n2{Z + (size_t)row0 * ZLD + ZGR, (const bf16_t*)(p.ws + OFF_WBG) + (size_t)col0 * D, ZLD, D, true};
        gemm_core<true>(Z + (size_t)row0 * ZLD + ZQ, ZLD, (const bf16_t*)(p.ws + OFF_WBA) + (size_t)col0 * D, D, D, acc, smem, pref, n2); }
      u32x2 y1[4][4];
#pragma unroll
      for (int mi = 0; mi < 4; ++mi) {
        const int row = row0 + wr * 64 + mi * 16 + x;
        const bf16_t* g = Z + (size_t)row * ZLD + ZGA + col0 + wc * 64 + quad * 4;
#pragma unroll
        for (int ni = 0; ni < 4; ++ni) {
          const u32x2 gg = *(const u32x2*)(g + ni * 16);
          y1[mi][ni].x = cvt_pk(acc[mi][ni][0] * sigmoidf_(bflo(gg.x)), acc[mi][ni][1] * sigmoidf_(bfhi(gg.x)));
          y1[mi][ni].y = cvt_pk(acc[mi][ni][2] * sigmoidf_(bflo(gg.y)), acc[mi][ni][3] * sigmoidf_(bfhi(gg.y)));
        }
      }
      zero_acc(acc);
      gemm_core<true>(Z + (size_t)row0 * ZLD + ZGR, ZLD, (const bf16_t*)(p.ws + OFF_WBG) + (size_t)col0 * D, D, D, acc, smem, true, nx);
#pragma unroll
      for (int mi = 0; mi < 4; ++mi) {
        const int row = row0 + wr * 64 + mi * 16 + x;
        const bf16_t* g = Z + (size_t)row * ZLD + ZGB + col0 + wc * 64 + quad * 4;
#pragma unroll
        for (int ni = 0; ni < 4; ++ni) {
          const u32x2 gg = *(const u32x2*)(g + ni * 16);
          const float y0 = bflo(y1[mi][ni].x) + sigmoidf_(bflo(gg.x)) * acc[mi][ni][0];
          const float y1f = bfhi(y1[mi][ni].x) + sigmoidf_(bfhi(gg.x)) * acc[mi][ni][1];
          const float y2 = bflo(y1[mi][ni].y) + sigmoidf_(bflo(gg.y)) * acc[mi][ni][2];
          const float y3 = bfhi(y1[mi][ni].y) + sigmoidf_(bfhi(gg.y)) * acc[mi][ni][3];
          y1[mi][ni].x = cvt_pk(y0, y1f); y1[mi][ni].y = cvt_pk(y2, y3);
        }
      }
      store_tile_bf16(y1, Hb + (size_t)(row0 + wr * 64) * D + col0 + wc * 64, D, smem, wid, lane);
    } else {
      bool pf = pref;
      if (MODE == 1 && K == D && split) {
        const float* Y32 = (const float*)(p.ws + OFF_Y32);
#pragma unroll 1
        for (int i = 0; i < 32; ++i) {
          const int idx = i * 256 + tid, rr2 = idx >> 6, c4 = idx & 63;
          const f32x4 v = *(const f32x4*)(Y32 + (size_t)(row0 - NTOK + rr2) * D + kofs + c4 * 4);
          u32x2 w; w.x = cvt_pk(v[0], v[1]); w.y = cvt_pk(v[2], v[3]);
          *(u32x2*)(Hb + (size_t)(row0 + rr2) * D + kofs + c4 * 4) = w;
        }
        asm volatile("s_waitcnt vmcnt(0)" ::: "memory");
        pf = false;
      }
      gemm_core<true>(A + (size_t)row0 * lda + kofs, lda, W + (size_t)col0 * K + kofs, K, klen, acc, smem, pf, nx);
      if (MODE == 1) {
        const bool isctx = row0 >= NTOK;
        const float* gt = MOD + ((size_t)(l * 2 + (isctx ? 1 : 0)) * 6 + gate_idx) * D + col0 + wc * 64 + quad * 4;
        f32x4 gv[4];
#pragma unroll
        for (int ni = 0; ni < 4; ++ni) gv[ni] = *(const f32x4*)(gt + ni * 16);
        if (split) {
#pragma unroll
          for (int mi = 0; mi < 4; ++mi) {
            const int row = row0 + wr * 64 + mi * 16 + x;
            float* dst = XC + (size_t)(row - NTOK) * D + col0 + wc * 64 + quad * 4;
#pragma unroll
            for (int ni = 0; ni < 4; ++ni) {
              const f32x4 v = gv[ni] * acc[mi][ni];
#pragma unroll
              for (int r = 0; r < 4; ++r) unsafeAtomicAdd(dst + ni * 16 + r, v[r]);
            }
          }
        } else {
#pragma unroll
          for (int mi = 0; mi < 4; ++mi)
#pragma unroll
            for (int ni = 0; ni < 4; ++ni) acc[mi][ni] = gv[ni] * acc[mi][ni];
          const size_t tofs = (size_t)(isctx ? row0 - NTOK + wr * 64 : row0 + wr * 64) * D + col0 + wc * 64;
          resid_tile_f32(acc, (isctx ? xsrc_ctx : xsrc_lat) + tofs, (isctx ? XC : p.out) + tofs, D, smem, wid, lane);
        }
      } else {
        bf16_t* U = Z;
        u32x2 pk[4][4];
#pragma unroll
        for (int mi = 0; mi < 4; ++mi)
#pragma unroll
          for (int ni = 0; ni < 4; ++ni) {
            f32x4 v = acc[mi][ni];
#pragma unroll
            for (int r = 0; r < 4; ++r) { const float a = fmaxf(v[r], 0.f); v[r] = a * a; }
            pk[mi][ni].x = cvt_pk(v[0], v[1]); pk[mi][ni].y = cvt_pk(v[2], v[3]);
          }
        store_tile_bf16(pk, U + (size_t)(row0 + wr * 64) * DFF + col0 + wc * 64, DFF, smem, wid, lane);
      }
    }
  }
}

__device__ void phase_merge_ctx(const Params& p, unsigned char* smem) {
  const bf16_t* Z = (const bf16_t*)(p.ws + OFF_Z);
  float* Y32 = (float*)(p.ws + OFF_Y32);
  for (int u = gemm_bid(); u < 128; u += gridDim.x) {
    const int ks = u >> 4, r = u & 15, br = ks >> 2, kofs = (ks & 3) * 256, row0 = NTOK + (r & 1) * 128, col0 = (r >> 1) * 128;
    f32x4 acc[4][4];
    zero_acc(acc);
    const GNext nx{nullptr, nullptr, 0, 0, false};
    gemm_core<true>(Z + (size_t)row0 * ZLD + (br ? ZGR : ZQ) + kofs, ZLD, (const bf16_t*)(p.ws + (br ? OFF_WBG : OFF_WBA)) + (size_t)col0 * D + kofs, D, 256, acc, smem, false, nx);
    const int tid = opaque_tid(), lane = tid & 63, wid = tid >> 6, wr = wid >> 1, wc = wid & 1, x = lane & 15, quad = lane >> 4;
#pragma unroll
    for (int mi = 0; mi < 4; ++mi) {
      const int row = row0 + wr * 64 + mi * 16 + x;
      const bf16_t* g = Z + (size_t)row * ZLD + (br ? ZGB : ZGA) + col0 + wc * 64 + quad * 4;
      float* dst = Y32 + (size_t)(row - NTOK) * D + col0 + wc * 64 + quad * 4;
#pragma unroll
      for (int ni = 0; ni < 4; ++ni) {
        const u32x2 gg = *(const u32x2*)(g + ni * 16);
        unsafeAtomicAdd(dst + ni * 16 + 0, acc[mi][ni][0] * sigmoidf_(bflo(gg.x)));
        unsafeAtomicAdd(dst + ni * 16 + 1, acc[mi][ni][1] * sigmoidf_(bfhi(gg.x)));
        unsafeAtomicAdd(dst + ni * 16 + 2, acc[mi][ni][2] * sigmoidf_(bflo(gg.y)));
        unsafeAtomicAdd(dst + ni * 16 + 3, acc[mi][ni][3] * sigmoidf_(bfhi(gg.y)));
      }
    }
  }
}

__device__ __forceinline__ int win_src_col(int n) {
  if (n < 1280) return n;
  if (n < 1792) return 1536 + (n - 1280);
  if (n < 2304) return 2048 + (n - 1792);
  if (n < 3328) return 3584 + (n - 2304);
  if (n < 4352) return 4640 + (n - 3328);
  if (n < 5376) return 5664 + (n - 4352);
  if (n < 5632) return 1280 + (n - 5376);
  if (n < 6656) return 2560 + (n - 5632);
  if (n < 6688) return 4608 + (n - 6656);
  return -1;
}

__device__ __forceinline__ void convert_tile(const float* __restrict__ src, int ld_src, int k0, int sc0, int sc1, bf16_t* __restrict__ dst, int K, int n0,
                                             unsigned char* smem) {
  float* tile = (float*)smem;
  const int tid = opaque_tid();
  __syncthreads();
#pragma unroll
  for (int i = 0; i < 4; ++i) {
    const int k = (tid >> 4) + i * 16, c4 = (tid & 15) * 4;
    const int sc = (c4 < 32) ? sc0 : sc1;
    f32x4 v = (f32x4){0.f, 0.f, 0.f, 0.f};
    if (sc >= 0) v = *(const f32x4*)(src + (size_t)(k0 + k) * ld_src + sc + (c4 & 31));
    tile[k * 65 + c4 + 0] = v[0]; tile[k * 65 + c4 + 1] = v[1]; tile[k * 65 + c4 + 2] = v[2]; tile[k * 65 + c4 + 3] = v[3];
  }
  __syncthreads();
#pragma unroll
  for (int i = 0; i < 2; ++i) {
    const int id = tid + i * 256, n = id >> 3, kc = id & 7;
    u32x4 w;
    w.x = cvt_pk(tile[(kc * 8 + 0) * 65 + n], tile[(kc * 8 + 1) * 65 + n]);
    w.y = cvt_pk(tile[(kc * 8 + 2) * 65 + n], tile[(kc * 8 + 3) * 65 + n]);
    w.z = cvt_pk(tile[(kc * 8 + 4) * 65 + n], tile[(kc * 8 + 5) * 65 + n]);
    w.w = cvt_pk(tile[(kc * 8 + 6) * 65 + n], tile[(kc * 8 + 7) * 65 + n]);
    *(u32x4*)(dst + (size_t)(n0 + n) * K + k0 + kc * 8) = w;
  }
}

constexpr int CV_IN = (WIN_ROWS / 64) * (D / 64);
constexpr int CV_SQ = (D / 64) * (D / 64);
constexpr int CV_FF = (DFF / 64) * (D / 64);
constexpr int CV_TOTAL = CV_IN + 3 * CV_SQ + 2 * CV_FF;

__device__ void convert_task(const Params& p, int l, int t, unsigned char* smem) {
  if (t < CV_IN) {
    const int nt = t / 16, kt = t % 16, n0 = nt * 64;
    convert_tile(p.w_in + (size_t)l * D * D_IN_SRC, D_IN_SRC, kt * 64, win_src_col(n0), win_src_col(n0 + 32), (bf16_t*)(p.ws + OFF_WIN), D, n0, smem);
    return;
  }
  t -= CV_IN;
  if (t < 3 * CV_SQ) {
    const int which = t / CV_SQ, tt = t % CV_SQ, nt = tt / 16, kt = tt % 16, n0 = nt * 64;
    const float* src = (which == 0 ? p.w_ba : which == 1 ? p.w_bg : p.w_out) + (size_t)l * D * D;
    bf16_t* dst = (bf16_t*)(p.ws + (which == 0 ? OFF_WBA : which == 1 ? OFF_WBG : OFF_WO));
    convert_tile(src, D, kt * 64, n0, n0 + 32, dst, D, n0, smem);
    return;
  }
  t -= 3 * CV_SQ;
  if (t < CV_FF) {
    const int nt = t / 16, kt = t % 16, n0 = nt * 64;
    convert_tile(p.w_ff1 + (size_t)l * D * DFF, DFF, kt * 64, n0, n0 + 32, (bf16_t*)(p.ws + OFF_WF1), D, n0, smem);
    return;
  }
  t -= CV_FF;
  {
    const int nt = t / 64, kt = t % 64, n0 = nt * 64;
    convert_tile(p.w_ff2 + (size_t)l * DFF * D, D, kt * 64, n0, n0 + 32, (bf16_t*)(p.ws + OFF_WF2), DFF, n0, smem);
  }
}

constexpr int MOD_TASKS = DEPTH * 96;
__device__ void mod_task(const Params& p, int t, unsigned char* smem) {
  float* sc = (float*)smem;
  float* red = sc + 2 * D;
  const int tid = opaque_tid();
  __syncthreads();
  for (int i = tid; i < D; i += 256) { sc[i] = siluf_(p.c[i]); sc[D + i] = siluf_(p.c_ctx[i]); }
  __syncthreads();
  const int l = t / 96, col0 = (t % 96) * 64, kr = tid >> 4, cl = tid & 15;
  const float* w = p.w_mod + (size_t)l * D * 6 * D + col0 + cl * 4;
  f32x4 a0 = (f32x4){0.f, 0.f, 0.f, 0.f}, a1 = a0;
#pragma unroll 16
  for (int i = 0; i < 64; ++i) {
    const int k = kr + i * 16;
    const f32x4 wv = *(const f32x4*)(w + (size_t)k * 6 * D);
    a0 += wv * sc[k]; a1 += wv * sc[D + k];
  }
  *(f32x4*)(red + (kr * 16 + cl) * 8) = a0; *(f32x4*)(red + (kr * 16 + cl) * 8 + 4) = a1;
  __syncthreads();
  if (tid < 128) {
    const int c2 = tid >> 3, j = tid & 7;
    float sum = 0.f;
#pragma unroll
    for (int r = 0; r < 16; ++r) sum += red[(r * 16 + c2) * 8 + j];
    const int col = col0 + c2 * 4 + (j & 3);
    float* MOD = (float*)(p.ws + OFF_MOD);
    MOD[(size_t)(l * 2 + (j >> 2)) * 6 * D + col] = sum + p.b_mod[l * 6 * D + col];
  }
}
__device__ void rope_task(const Params& p, int t) {
  const int id = t * 256 + opaque_tid(), pos = id >> 4, i = id & 15;
  const double inv = exp2(-(double)i * (13.287712379549449 / 16.0));
  const double rev = (double)pos * inv * 0.15915494309189535;
  const float fr = (float)(rev - floor(rev));
  float* ROPE = (float*)(p.ws + OFF_ROPE);
  ROPE[id * 2 + 0] = __builtin_amdgcn_cosf(fr);
  ROPE[id * 2 + 1] = __builtin_amdgcn_sinf(fr);
}

__device__ void norm_task(const Params& p, int l, int t, int which, const float* xlat, const float* xctx) {
  const int tid = opaque_tid(), lane = tid & 63, wid = tid >> 6;
  const float* MOD = (const float*)(p.ws + OFF_MOD);
  bf16_t* H = (bf16_t*)(p.ws + OFF_H);
  const float* g = (which == 0 ? p.g_norm1 : p.g_norm2) + l * D;
  const bool isctx = t * 16 >= NTOK;
  const float* sh = MOD + ((size_t)(l * 2 + (isctx ? 1 : 0)) * 6 + which * 3 + 0) * D;
  const float* sc = sh + D;
  f32x4 gm[4], shv[4];
#pragma unroll
  for (int j = 0; j < 4; ++j) {
    const int c = j * 256 + lane * 4;
    const f32x4 gg = *(const f32x4*)(g + c), s = *(const f32x4*)(sc + c);
    gm[j] = gg * (s + 1.0f); shv[j] = *(const f32x4*)(sh + c);
  }
#pragma unroll
  for (int it = 0; it < 4; ++it) {
    const int row = t * 16 + it * 4 + wid;
    const float* xr = isctx ? (xctx + (size_t)(row - NTOK) * D) : (xlat + (size_t)row * D);
    f32x4 v[4];
    float ss = 0.f;
#pragma unroll
    for (int j = 0; j < 4; ++j) { v[j] = *(const f32x4*)(xr + j * 256 + lane * 4); ss += v[j][0] * v[j][0] + v[j][1] * v[j][1] + v[j][2] * v[j][2] + v[j][3] * v[j][3]; }
#pragma unroll
    for (int o = 32; o >= 1; o >>= 1) ss += __shfl_xor(ss, o);
    const float rstd = rsqrtf(ss * (1.0f / D) + EPS);
#pragma unroll
    for (int j = 0; j < 4; ++j) {
      const f32x4 h = v[j] * rstd * gm[j] + shv[j];
      u32x2 w; w.x = cvt_pk(h[0], h[1]); w.y = cvt_pk(h[2], h[3]);
      *(u32x2*)(H + (size_t)row * D + j * 256 + lane * 4) = w;
    }
  }
}

__device__ void attn_task(const Params& p, int l, int qb, int h, unsigned char* smem) {
  bf16_t* Z = (bf16_t*)(p.ws + OFF_Z);
  const bf16_t* VT = (const bf16_t*)(p.ws + OFF_VT);
  const int tid = opaque_tid(), lane = tid & 63, wid = tid >> 6, x = lane & 15, quad = lane >> 4;
  const int kh = h >> 2;
  const bool ctxq = qb >= (NTOK / 128);
  int lo = 0, nloc = 0;
  if (!ctxq) {
    lo = (qb - 1) * 128; if (lo < 0) lo = 0;
    int hi = (qb + 2) * 128; if (hi > NTOK) hi = NTOK;
    nloc = (hi - lo) >> 6;
  }
  const int ntiles = nloc + 4;
  unsigned char* sK = smem;
  unsigned char* sV = smem + 8192;
  bf16x8 qf[2][2];
#pragma unroll
  for (int qt = 0; qt < 2; ++qt)
#pragma unroll
    for (int kk = 0; kk < 2; ++kk)
      qf[qt][kk] = *(const bf16x8*)(Z + (size_t)(qb * 128 + wid * 32 + qt * 16 + x) * ZLD + ZQ + h * 64 + kk * 32 + quad * 8);
  const float sinkv = p.sink[l * 16 + h] * LOG2E;
  float mrun[2] = {sinkv, sinkv}, lrun[2];
  lrun[0] = lrun[1] = (quad == 0) ? 1.0f : 0.0f;
  f32x4 o[2][4];
#pragma unroll
  for (int qt = 0; qt < 2; ++qt)
#pragma unroll
    for (int dt = 0; dt < 4; ++dt) o[qt][dt] = (f32x4){0.f, 0.f, 0.f, 0.f};

  u32x4 rk[2], rv[2];
  auto gload = [&](int ti) {
    const int start = (ti < nloc) ? (lo + ti * 64) : (NTOK + (ti - nloc) * 64);
#pragma unroll
    for (int i = 0; i < 2; ++i) {
      const int id = tid + i * 256, rr = id >> 3, ch = id & 7;
      rk[i] = *(const u32x4*)(Z + (size_t)(start + rr) * ZLD + ZK + kh * 64 + ch * 8);
      rv[i] = *(const u32x4*)(VT + (size_t)(kh * 64 + rr) * R + start + ch * 8);
    }
  };
  gload(0);
  for (int ti = 0; ti < ntiles; ++ti) {
    __syncthreads();
#pragma unroll
    for (int i = 0; i < 2; ++i) {
      const int id = tid + i * 256, rr = id >> 3, ch = id & 7;
      *(u32x4*)(sK + rr * 128 + ((ch ^ (rr & 7)) << 4)) = rk[i];
      *(u32x4*)(sV + rr * 144 + ch * 16) = rv[i];
    }
    __syncthreads();
    const bool local = ti < nloc;
    const int start = local ? (lo + ti * 64) : 0;
    if (ti + 1 < ntiles) gload(ti + 1);
    f32x4 st[2][4];
#pragma unroll
    for (int t = 0; t < 4; ++t) {
      bf16x8 kf[2];
#pragma unroll
      for (int kk = 0; kk < 2; ++kk) { const int rr = t * 16 + x, ch = kk * 4 + quad; kf[kk] = *(const bf16x8*)(sK + rr * 128 + ((ch ^ (rr & 7)) << 4)); }
#pragma unroll
      for (int qt = 0; qt < 2; ++qt) {
        f32x4 a = (f32x4){0.f, 0.f, 0.f, 0.f};
        a = mfma16(kf[0], qf[qt][0], a);
        a = mfma16(kf[1], qf[qt][1], a);
        st[qt][t] = a;
      }
    }
    if (local) {
#pragma unroll
      for (int qt = 0; qt < 2; ++qt) {
        const int qpos = qb * 128 + wid * 32 + qt * 16 + x;
#pragma unroll
        for (int t = 0; t < 4; ++t)
#pragma unroll
          for (int r = 0; r < 4; ++r) {
            const int dd = qpos - (start + t * 16 + quad * 4 + r);
            if (dd > 128 || dd < -128) st[qt][t][r] = -1e30f;
          }
      }
    }
    bf16x8 pb[2][2];
#pragma unroll
    for (int qt = 0; qt < 2; ++qt) {
      float mx = st[qt][0][0];
#pragma unroll
      for (int t = 0; t < 4; ++t)
#pragma unroll
        for (int r = 0; r < 4; ++r) mx = fmaxf(mx, st[qt][t][r]);
      mx = fmaxf(mx, __shfl_xor(mx, 16)); mx = fmaxf(mx, __shfl_xor(mx, 32));
      const float mnew = fmaxf(mrun[qt], mx);
      const float alpha = __builtin_amdgcn_exp2f(mrun[qt] - mnew);
      mrun[qt] = mnew;
      float ps = 0.f;
#pragma unroll
      for (int t = 0; t < 4; ++t)
#pragma unroll
        for (int r = 0; r < 4; ++r) { const float e = __builtin_amdgcn_exp2f(st[qt][t][r] - mnew); st[qt][t][r] = e; ps += e; }
      lrun[qt] = lrun[qt] * alpha + ps;
#pragma unroll
      for (int dt = 0; dt < 4; ++dt) o[qt][dt] *= alpha;
#pragma unroll
      for (int hh = 0; hh < 2; ++hh) {
        u32x4 w;
        w.x = cvt_pk(st[qt][2 * hh][0], st[qt][2 * hh][1]); w.y = cvt_pk(st[qt][2 * hh][2], st[qt][2 * hh][3]);
        w.z = cvt_pk(st[qt][2 * hh + 1][0], st[qt][2 * hh + 1][1]); w.w = cvt_pk(st[qt][2 * hh + 1][2], st[qt][2 * hh + 1][3]);
        pb[qt][hh] = __builtin_bit_cast(bf16x8, w);
      }
    }
#pragma unroll
    for (int dt = 0; dt < 4; ++dt)
#pragma unroll
      for (int hh = 0; hh < 2; ++hh) {
        const unsigned char* vr = sV + (dt * 16 + x) * 144 + quad * 8;
        const u32x2 v0 = *(const u32x2*)(vr + (2 * hh) * 32), v1 = *(const u32x2*)(vr + (2 * hh + 1) * 32);
        u32x4 w; w.x = v0.x; w.y = v0.y; w.z = v1.x; w.w = v1.y;
        const bf16x8 va = __builtin_bit_cast(bf16x8, w);
#pragma unroll
        for (int qt = 0; qt < 2; ++qt) o[qt][dt] = mfma16(va, pb[qt][hh], o[qt][dt]);
      }
  }
  u32x2 opk[2][4];
#pragma unroll
  for (int qt = 0; qt < 2; ++qt) {
    float lt = lrun[qt];
    lt += __shfl_xor(lt, 16); lt += __shfl_xor(lt, 32);
    const float inv = 1.0f / lt;
#pragma unroll
    for (int dt = 0; dt < 4; ++dt) { opk[qt][dt].x = cvt_pk(o[qt][dt][0] * inv, o[qt][dt][1] * inv); opk[qt][dt].y = cvt_pk(o[qt][dt][2] * inv, o[qt][dt][3] * inv); }
  }
  {
    const unsigned sw = (unsigned)(size_t)(const LAS unsigned char*)smem + 32768u + (unsigned)wid * 4608u;
    const unsigned wa = sw + (unsigned)(x * 144 + quad * 8), rr = sw + (unsigned)((lane >> 3) * 144 + (lane & 7) * 16);
#pragma unroll
    for (int qt = 0; qt < 2; ++qt) {
      asm volatile("ds_write_b64 %0, %1" :: "v"(wa + qt * 2304), "v"(opk[qt][0]) : "memory");
      asm volatile("ds_write_b64 %0, %1 offset:32" :: "v"(wa + qt * 2304), "v"(opk[qt][1]) : "memory");
      asm volatile("ds_write_b64 %0, %1 offset:64" :: "v"(wa + qt * 2304), "v"(opk[qt][2]) : "memory");
      asm volatile("ds_write_b64 %0, %1 offset:96" :: "v"(wa + qt * 2304), "v"(opk[qt][3]) : "memory");
    }
    u32x4 o0, o1, o2, o3;
    asm volatile("ds_read_b128 %0, %1" : "=v"(o0) : "v"(rr) : "memory");
    asm volatile("ds_read_b128 %0, %1 offset:1152" : "=v"(o1) : "v"(rr) : "memory");
    asm volatile("ds_read_b128 %0, %1 offset:2304" : "=v"(o2) : "v"(rr) : "memory");
    asm volatile("ds_read_b128 %0, %1 offset:3456" : "=v"(o3) : "v"(rr) : "memory");
    asm volatile("s_waitcnt lgkmcnt(0)" : "+v"(o0), "+v"(o1), "+v"(o2), "+v"(o3));
    bf16_t* g = Z + (size_t)(qb * 128 + wid * 32 + (lane >> 3)) * ZLD + ZQ + h * 64 + (lane & 7) * 8;
    *(u32x4*)(g) = o0;
    *(u32x4*)(g + (size_t)8 * ZLD) = o1;
    *(u32x4*)(g + (size_t)16 * ZLD) = o2;
    *(u32x4*)(g + (size_t)24 * ZLD) = o3;
  }
}

__device__ __forceinline__ size_t st_index(int dir, int c, int h) { return ((size_t)(dir * NCH + c) * 4 + h) * (256 * 128); }

template <int DIR>
__device__ __forceinline__ float gla_g1_scan(const float* sga, const float (&w)[16], float bias, const u32x4 (&qrow)[8], const u32x4 (&krow)[8],
                                             bf16_t* qdst, bf16_t* kdst, int dld, bf16_t* skrow) {
  float run = 0.f;
#pragma nounroll
  for (int gg = 0; gg < 8; ++gg) {
    const int g = DIR ? 7 - gg : gg;
    u32x4 qg, kg;
    switch (g) {
      case 0: qg = qrow[0]; kg = krow[0]; break;
      case 1: qg = qrow[1]; kg = krow[1]; break;
      case 2: qg = qrow[2]; kg = krow[2]; break;
      case 3: qg = qrow[3]; kg = krow[3]; break;
      case 4: qg = qrow[4]; kg = krow[4]; break;
      case 5: qg = qrow[5]; kg = krow[5]; break;
      case 6: qg = qrow[6]; kg = krow[6]; break;
      default: qg = qrow[7]; kg = krow[7]; break;
    }
    unsigned kprev = 0;
#pragma unroll
    for (int j = 0; j < 8; ++j) {
      const int tl = DIR ? 7 - j : j;
      const int t = g * 8 + tl;
      const float* gr = sga + t * 32 + DIR * 16;
      const f32x4 g0 = *(const f32x4*)gr, g1 = *(const f32x4*)(gr + 4), g2 = *(const f32x4*)(gr + 8), g3 = *(const f32x4*)(gr + 12);
      float xg = bias;
      xg += g0[0] * w[0] + g0[1] * w[1] + g0[2] * w[2] + g0[3] * w[3];
      xg += g1[0] * w[4] + g1[1] * w[5] + g1[2] * w[6] + g1[3] * w[7];
      xg += g2[0] * w[8] + g2[1] * w[9] + g2[2] * w[10] + g2[3] * w[11];
      xg += g3[0] * w[12] + g3[1] * w[13] + g3[2] * w[14] + g3[3] * w[15];
      const float ls = fminf(xg, 0.f) - __logf(1.0f + __expf(-fabsf(xg)));
      run += ls * (1.0f / 16.0f);
      const unsigned qw = qg[tl >> 1], kw = kg[tl >> 1];
      const float qv = (tl & 1) ? bfhi(qw) : bflo(qw), kv = (tl & 1) ? bfhi(kw) : bflo(kw);
      const unsigned kin = cvt_pk(kv * __expf(-run), 0.f) & 0xffffu;
      qdst[(size_t)t * dld] = f2bf(qv * __expf(run) * 0.08838834764831845f);
      kdst[(size_t)t * dld] = (bf16_t)kin;
      if ((j & 1) == 0) kprev = kin;
      else {
        const unsigned pr = DIR ? (kin | (kprev << 16)) : (kprev | (kin << 16));
        *(unsigned*)(skrow + (t & ~1)) = pr;
      }
    }
  }
  return run;
}

__device__ void gla_g1_task(const Params& p, int l, int c, int h, unsigned char* smem) {
  bf16_t* Z = (bf16_t*)(p.ws + OFF_Z);
  bf16_t* Hb = (bf16_t*)(p.ws + OFF_H);
  const bf16_t* GVT = (const bf16_t*)(p.ws + OFF_GVT);
  const float* GA = (const float*)(p.ws + OFF_GA);
  float* DL = (float*)(p.ws + OFF_DL);
  bf16_t* ST = (bf16_t*)(p.ws + OFF_ST);
  const int tid = opaque_tid(), lane = tid & 63, wid = tid >> 6, x = lane & 15, quad = lane >> 4;
  const int dir = tid >> 7, d = tid & 127, row0 = c * 64;
  float* sga = (float*)smem;
  bf16_t* skot = (bf16_t*)(smem + 8192);
  float* sdl = (float*)(smem + 8192 + 36864);
  __syncthreads();
#pragma unroll
  for (int i = 0; i < 2; ++i) { const int id = tid + i * 256; *(f32x4*)(sga + id * 4) = *(const f32x4*)(GA + (size_t)row0 * 32 + id * 4); }
#pragma unroll
  for (int i = 0; i < 8; ++i) {
    const int id = tid + i * 256, which = id >> 10, t = (id >> 4) & 63, ch = id & 15;
    const u32x4 v = *(const u32x4*)(Z + (size_t)(row0 + t) * ZLD + (which ? ZGQ : ZGK) + h * 128 + ch * 8);
    bf16_t* dst = skot + (which * 128 + ch * 8) * 72 + t;
    dst[0 * 72] = (bf16_t)(v.x & 0xffff); dst[1 * 72] = (bf16_t)(v.x >> 16); dst[2 * 72] = (bf16_t)(v.y & 0xffff); dst[3 * 72] = (bf16_t)(v.y >> 16);
    dst[4 * 72] = (bf16_t)(v.z & 0xffff); dst[5 * 72] = (bf16_t)(v.z >> 16); dst[6 * 72] = (bf16_t)(v.w & 0xffff); dst[7 * 72] = (bf16_t)(v.w >> 16);
  }
  float w[16];
#pragma unroll
  for (int r = 0; r < 16; ++r) w[r] = p.w_decay[((size_t)(l * 2 + dir) * 16 + r) * 512 + h * 128 + d];
  const float bias = p.b_decay[(size_t)(l * 2 + dir) * 512 + h * 128 + d];
  __syncthreads();
  u32x4 qrow[8], krow[8];
#pragma unroll
  for (int i = 0; i < 8; ++i) { krow[i] = *(const u32x4*)(skot + (size_t)d * 72 + i * 8); qrow[i] = *(const u32x4*)(skot + (size_t)(128 + d) * 72 + i * 8); }
  asm volatile("s_waitcnt lgkmcnt(0)" ::: "memory");
  __syncthreads();
  bf16_t* qdst = dir ? (Hb + (size_t)row0 * D + h * 128 + d) : (Z + (size_t)row0 * ZLD + ZGQ + h * 128 + d);
  bf16_t* kdst = dir ? (Hb + (size_t)row0 * D + 512 + h * 128 + d) : (Z + (size_t)row0 * ZLD + ZGK + h * 128 + d);
  float run;
  if (dir == 0) run = gla_g1_scan<0>(sga, w, bias, qrow, krow, qdst, kdst, ZLD, skot + (size_t)d * 72);
  else run = gla_g1_scan<1>(sga, w, bias, qrow, krow, qdst, kdst, D, skot + (size_t)(128 + d) * 72);
  const float dlast = __expf(run);
  DL[((size_t)(dir * NCH + c) * 4 + h) * 128 + d] = dlast;
  sdl[dir * 128 + d] = dlast;
  __syncthreads();
  bf16x8 vb[4][2];
#pragma unroll
  for (int jt = 0; jt < 4; ++jt)
#pragma unroll
    for (int kk = 0; kk < 2; ++kk)
      vb[jt][kk] = *(const bf16x8*)(GVT + (size_t)(h * 256 + wid * 64 + jt * 16 + x) * R + row0 + kk * 32 + quad * 8);
#pragma unroll
  for (int dd = 0; dd < 2; ++dd) {
    bf16_t* dst = ST + st_index(dd, c, h);
#pragma unroll
    for (int ih = 0; ih < 2; ++ih) {
      u32x2 pk[4][4];
#pragma unroll
      for (int il = 0; il < 4; ++il) {
        const int it = ih * 4 + il;
        bf16x8 ka[2];
#pragma unroll
        for (int kk = 0; kk < 2; ++kk) ka[kk] = *(const bf16x8*)(skot + (dd * 128 + it * 16 + x) * 72 + kk * 32 + quad * 8);
        const f32x4 sc = *(const f32x4*)(sdl + dd * 128 + it * 16 + quad * 4);
#pragma unroll
        for (int jt = 0; jt < 4; ++jt) {
          f32x4 a = (f32x4){0.f, 0.f, 0.f, 0.f};
          a = mfma16(ka[0], vb[jt][0], a);
          a = mfma16(ka[1], vb[jt][1], a);
          a = a * sc;
          pk[jt][il].x = cvt_pk(a[0], a[1]); pk[jt][il].y = cvt_pk(a[2], a[3]);
        }
      }
      store_tile_bf16(pk, dst + (size_t)(wid * 64) * 128 + ih * 64, 128, smem, wid, lane, 46080u);
    }
  }
}

constexpr int G2_TASKS = 2 * 4 * 32;
constexpr int ATTN_P2 = 48, ATTN_P3 = 512;
__device__ void gla_g2_task(const Params& p, int t) {
  bf16_t* ST = (bf16_t*)(p.ws + OFF_ST);
  const float* DL = (const float*)(p.ws + OFF_DL);
  const int dir = t >> 7, h = (t >> 5) & 3, slab = t & 31;
  const int e0 = (slab * 256 + opaque_tid()) * 4;
  const int dk = e0 & 127;
  f32x4 S = (f32x4){0.f, 0.f, 0.f, 0.f};
  constexpr int BATCH = 10;
  for (int s0 = 0; s0 < NCH; s0 += BATCH) {
    u32x2 kv[BATCH]; f32x4 dl[BATCH];
#pragma unroll
    for (int j = 0; j < BATCH; ++j) {
      const int s = s0 + j;
      const int c = dir ? (259 - s) : (s < 4 ? 256 + s : s - 4);
      kv[j] = *(const u32x2*)(ST + st_index(dir, c, h) + e0);
      dl[j] = *(const f32x4*)(DL + ((size_t)(dir * NCH + c) * 4 + h) * 128 + dk);
    }
#pragma unroll
    for (int j = 0; j < BATCH; ++j) {
      const int s = s0 + j;
      const int c = dir ? (259 - s) : (s < 4 ? 256 + s : s - 4);
      u32x2 w; w.x = cvt_pk(S[0], S[1]); w.y = cvt_pk(S[2], S[3]);
      *(u32x2*)(ST + st_index(dir, c, h) + e0) = w;
      S[0] = S[0] * dl[j][0] + bflo(kv[j].x); S[1] = S[1] * dl[j][1] + bfhi(kv[j].x);
      S[2] = S[2] * dl[j][2] + bflo(kv[j].y); S[3] = S[3] * dl[j][3] + bfhi(kv[j].y);
    }
  }
}

__device__ void gla_g3_task(const Params& p, int l, int c, int h, unsigned char* smem) {
  bf16_t* Z = (bf16_t*)(p.ws + OFF_Z);
  const bf16_t* Hb = (const bf16_t*)(p.ws + OFF_H);
  const bf16_t* GVT = (const bf16_t*)(p.ws + OFF_GVT);
  const bf16_t* ST = (const bf16_t*)(p.ws + OFF_ST);
  const int tid = opaque_tid(), lane = tid & 63, wid = tid >> 6, x = lane & 15, quad = lane >> 4;
  const int row0 = c * 64, toki = wid * 16 + x;
  const bf16_t* Sg0 = ST + st_index(0, c, h) + (size_t)(tid >> 4) * 128 + (((tid & 15) ^ ((tid >> 4) & 15)) * 8);
  const bf16_t* Sg1 = ST + st_index(1, c, h) + (size_t)(tid >> 4) * 128 + (((tid & 15) ^ ((tid >> 4) & 15)) * 8);
  unsigned char* sdst = smem + tid * 16;
  const bf16_t* sp = Sg0;
#define G3_DMA(g) do { if ((g) == 4) sp = Sg1; unsigned char* _d = sdst + ((g) & 3) * 16384; \
    _Pragma("unroll") for (int _i = 0; _i < 4; ++_i) { __builtin_amdgcn_global_load_lds((const unsigned*)(sp), (LAS unsigned*)(_d + _i * 4096), 16, 0, 0); sp += 2048; asm volatile("" : "+v"(sp)); } } while (0)
  __syncthreads();
  G3_DMA(0); G3_DMA(1); G3_DMA(2);
  const bf16_t* qbase0 = Z + (size_t)row0 * ZLD + ZGQ + h * 128;
  const bf16_t* kbase0 = Z + (size_t)row0 * ZLD + ZGK + h * 128;
  const bf16_t* qbase1 = Hb + (size_t)row0 * D + h * 128;
  const bf16_t* kbase1 = Hb + (size_t)row0 * D + 512 + h * 128;
  bf16x8 qb[2][4];
#pragma unroll
  for (int kk = 0; kk < 4; ++kk) {
    qb[0][kk] = *(const bf16x8*)(qbase0 + (size_t)toki * ZLD + kk * 32 + quad * 8);
    qb[1][kk] = *(const bf16x8*)(qbase1 + (size_t)toki * D + kk * 32 + quad * 8);
  }
  f32x4 atot[4];
#pragma unroll
  for (int t = 0; t < 4; ++t) atot[t] = (f32x4){0.f, 0.f, 0.f, 0.f};
#pragma unroll
  for (int dir = 0; dir < 2; ++dir) {
    const bf16_t* kb = dir ? kbase1 : kbase0;
    const int ld = dir ? D : ZLD;
    bf16x8 kf[4][4];
#pragma unroll
    for (int t = 0; t < 4; ++t)
#pragma unroll
      for (int kk = 0; kk < 4; ++kk) kf[t][kk] = *(const bf16x8*)(kb + (size_t)(t * 16 + x) * ld + kk * 32 + quad * 8);
#pragma unroll
    for (int t = 0; t < 4; ++t) {
      f32x4 a = (f32x4){0.f, 0.f, 0.f, 0.f};
#pragma unroll
      for (int kk = 0; kk < 4; ++kk) a = mfma16(kf[t][kk], qb[dir][kk], a);
#pragma unroll
      for (int r = 0; r < 4; ++r) {
        const int tokj = t * 16 + quad * 4 + r;
        const bool keep = dir ? (tokj >= toki) : (tokj <= toki);
        atot[t][r] += keep ? a[r] : 0.f;
      }
    }
    __builtin_amdgcn_sched_barrier(0);
  }
  f32x4 o[16];
#pragma unroll
  for (int dt = 0; dt < 16; ++dt) o[dt] = (f32x4){0.f, 0.f, 0.f, 0.f};
  const unsigned lbase = (unsigned)(size_t)(const LAS unsigned char*)smem;
  unsigned akk[4];
#pragma unroll
  for (int kk = 0; kk < 4; ++kk) akk[kk] = lbase + (unsigned)(x * 256 + (((kk * 4 + quad) ^ x) << 4));
#pragma unroll
  for (int g = 0; g < 8; ++g) {
    if (g < 6) asm volatile("s_waitcnt vmcnt(8)" ::: "memory"); else if (g == 6) asm volatile("s_waitcnt vmcnt(4)" ::: "memory"); else asm volatile("s_waitcnt vmcnt(0)" ::: "memory");
    __builtin_amdgcn_s_barrier(); asm volatile("" ::: "memory");
    if (g + 3 < 8) G3_DMA(g + 3);
    const int dir = g >> 2;
#pragma unroll
    for (int half = 0; half < 2; ++half) {
      bf16x8 sf[2][4];
#pragma unroll
      for (int dl = 0; dl < 2; ++dl)
#pragma unroll
        for (int kk = 0; kk < 4; ++kk)
          asm volatile("ds_read_b128 %0, %1 offset:%2" : "=v"(sf[dl][kk]) : "v"(akk[kk]), "n"((g & 3) * 16384 + (half * 2 + dl) * 4096));
      asm volatile("s_waitcnt lgkmcnt(0)" : "+v"(sf[0][0]), "+v"(sf[0][1]), "+v"(sf[0][2]), "+v"(sf[0][3]), "+v"(sf[1][0]), "+v"(sf[1][1]), "+v"(sf[1][2]), "+v"(sf[1][3]));
#pragma unroll
      for (int dl = 0; dl < 2; ++dl) {
        const int dt = (g & 3) * 4 + half * 2 + dl;
#pragma unroll
        for (int kk = 0; kk < 4; ++kk) o[dt] = mfma16(sf[dl][kk], qb[dir][kk], o[dt]);
      }
    }
  }
#undef G3_DMA
  bf16x8 pb[2];
#pragma unroll
  for (int hh = 0; hh < 2; ++hh) {
    u32x4 w;
    w.x = cvt_pk(atot[2 * hh][0], atot[2 * hh][1]); w.y = cvt_pk(atot[2 * hh][2], atot[2 * hh][3]);
    w.z = cvt_pk(atot[2 * hh + 1][0], atot[2 * hh + 1][1]); w.w = cvt_pk(atot[2 * hh + 1][2], atot[2 * hh + 1][3]);
    pb[hh] = __builtin_bit_cast(bf16x8, w);
  }
  {
    const bf16_t* vbase = GVT + (size_t)(h * 256 + x) * R + row0 + quad * 4;
#pragma unroll
    for (int vh = 0; vh < 2; ++vh) {
      u32x2 vf[8][4];
#pragma unroll
      for (int d8 = 0; d8 < 8; ++d8)
#pragma unroll
        for (int m = 0; m < 4; ++m) vf[d8][m] = *(const u32x2*)(vbase + (size_t)((vh * 8 + d8) * 16) * R + m * 16);
#pragma unroll
      for (int d8 = 0; d8 < 8; ++d8)
#pragma unroll
        for (int hh = 0; hh < 2; ++hh) {
          u32x4 w; w.x = vf[d8][2 * hh].x; w.y = vf[d8][2 * hh].y; w.z = vf[d8][2 * hh + 1].x; w.w = vf[d8][2 * hh + 1].y;
          o[vh * 8 + d8] = mfma16(__builtin_bit_cast(bf16x8, w), pb[hh], o[vh * 8 + d8]);
        }
      __builtin_amdgcn_sched_barrier(0);
    }
  }
  float ss = 0.f;
#pragma unroll
  for (int dt = 0; dt < 16; ++dt) ss += o[dt][0] * o[dt][0] + o[dt][1] * o[dt][1] + o[dt][2] * o[dt][2] + o[dt][3] * o[dt][3];
  ss += __shfl_xor(ss, 16); ss += __shfl_xor(ss, 32);
  const float rstd = rsqrtf(ss * (1.0f / 256.0f) + EPS);
  const float* gain = p.gla_gain + l * 256 + quad * 4;
  __builtin_amdgcn_s_barrier();
  asm volatile("" ::: "memory");
  unsigned char* sw = smem + wid * 8448;
  bf16_t* grow = Z + (size_t)(row0 + wid * 16) * ZLD + ZGR + h * 256;
  {
    u32x4 gt[8];
#pragma unroll
    for (int it = 0; it < 8; ++it) gt[it] = *(const u32x4*)(grow + (size_t)(it * 2 + (lane >> 5)) * ZLD + (lane & 31) * 8);
#pragma unroll
    for (int it = 0; it < 8; ++it) *(u32x4*)(sw + (it * 2 + (lane >> 5)) * 528 + (lane & 31) * 16) = gt[it];
  }
  unsigned char* mine = sw + x * 528 + quad * 8;
#pragma unroll
  for (int dt = 0; dt < 16; ++dt) {
    const f32x4 gn = *(const f32x4*)(gain + dt * 16);
    const u32x2 gg = *(const u32x2*)(mine + dt * 32);
    const float y0 = o[dt][0] * rstd * gn[0] * siluf_(bflo(gg.x)), y1 = o[dt][1] * rstd * gn[1] * siluf_(bfhi(gg.x));
    const float y2 = o[dt][2] * rstd * gn[2] * siluf_(bflo(gg.y)), y3 = o[dt][3] * rstd * gn[3] * siluf_(bfhi(gg.y));
    u32x2 w; w.x = cvt_pk(y0, y1); w.y = cvt_pk(y2, y3);
    *(u32x2*)(mine + dt * 32) = w;
  }
#pragma unroll
  for (int it = 0; it < 8; ++it) {
    const u32x4 v = *(const u32x4*)(sw + (it * 2 + (lane >> 5)) * 528 + (lane & 31) * 16);
    *(u32x4*)(grow + (size_t)(it * 2 + (lane >> 5)) * ZLD + (lane & 31) * 8) = v;
  }
}


#define XB_TMO      128
#define XB_XCNT(j)  (256  + 64 * (j))
#define XB_XSUB(j)  (1280 + 64 * (j))
#define XB_XGEN(j)  (2304 + 64 * (j))
#define XB_TOP      3328
#define XB_TOPGEN   3392
#define XCD_BAR_WORDS 3456
#define XB_SPIN_CAP (1u << 22)
__device__ __forceinline__ unsigned xb_ld(unsigned* p)              { return __hip_atomic_load(p, __ATOMIC_RELAXED, __HIP_MEMORY_SCOPE_AGENT); }
__device__ __forceinline__ unsigned xb_add(unsigned* p, unsigned v) { return __hip_atomic_fetch_add(p, v, __ATOMIC_RELAXED, __HIP_MEMORY_SCOPE_AGENT); }
__device__ __forceinline__ unsigned xb_xcc_id() { return (unsigned)__builtin_amdgcn_s_getreg((3 << 11) | 20) & 0xFu; }
#define XB_SPIN(cond, bar) do { unsigned _sp = 0; while (cond) { __builtin_amdgcn_s_sleep(1); \
    if ((++_sp & 255u) == 0u) { if (xb_ld(&(bar)[XB_TMO])) break; if (_sp > XB_SPIN_CAP) { atomicAdd(&(bar)[XB_TMO], 1u); break; } } } } while (0)
struct XcdBarrier { unsigned* bar; unsigned x; volatile LAS unsigned* st; };
__device__ __forceinline__ XcdBarrier xcd_barrier_post(unsigned* bar, volatile LAS unsigned* st) {
  XcdBarrier b; b.bar = bar; b.x = xb_xcc_id(); b.st = st;
  if (threadIdx.x == 0) (void)xb_add(&bar[XB_XCNT(b.x)], 1u);
  return b;
}
__device__ __forceinline__ void xcd_barrier_complete(unsigned* bar, unsigned x, unsigned& nloc, unsigned& nx) {
  const unsigned G = gridDim.x * gridDim.y * gridDim.z;
  unsigned sum, cnt, mine, sp = 0u;
  for (;;) {
    sum = 0u; cnt = 0u; mine = 0u;
#pragma unroll
    for (unsigned j = 0; j < 16; ++j) { const unsigned c = xb_ld(&bar[XB_XCNT(j)]); sum += c; cnt += (c > 0u) ? 1u : 0u; mine = (j == x) ? c : mine; }
    if (sum == G) break;
    __builtin_amdgcn_s_sleep(1);
    if ((++sp & 255u) == 0u) { if (xb_ld(&bar[XB_TMO])) break; if (sp > XB_SPIN_CAP) { atomicAdd(&bar[XB_TMO], 1u); break; } }
  }
  nloc = mine > 0u ? mine : 1u; nx = cnt > 0u ? cnt : 1u;
}
__device__ __forceinline__ void xcd_barrier(const XcdBarrier& b) {
  asm volatile("s_waitcnt vmcnt(0)" ::: "memory");
  __syncthreads();
  if (threadIdx.x == 0) {
    unsigned* bar = b.bar;
    __builtin_amdgcn_s_waitcnt(0);
    unsigned nloc = b.st[0], nx = b.st[1];
    if (nloc == 0u) { xcd_barrier_complete(bar, b.x, nloc, nx); b.st[0] = nloc; b.st[1] = nx; }
    const unsigned old = xb_add(&bar[XB_XSUB(b.x)], 1u);
    const unsigned gen = old / nloc;
    if (old + 1u == (gen + 1u) * nloc) {
      __builtin_amdgcn_fence(__ATOMIC_RELEASE, "agent");
      asm volatile("s_waitcnt vmcnt(0)" ::: "memory");
      const unsigned og = xb_add(&bar[XB_TOP], 1u);
      const unsigned tg = og / nx;
      if (og + 1u == (tg + 1u) * nx) xb_add(&bar[XB_TOPGEN], 1u);
      else XB_SPIN(xb_ld(&bar[XB_TOPGEN]) == tg, bar);
      __builtin_amdgcn_fence(__ATOMIC_ACQUIRE, "agent");
      xb_add(&bar[XB_XGEN(b.x)], 1u);
      asm volatile("s_waitcnt vmcnt(0)" ::: "memory");
    } else {
      XB_SPIN(xb_ld(&bar[XB_XGEN(b.x)]) == gen, bar);
      __builtin_amdgcn_fence(__ATOMIC_ACQUIRE, "agent");
      asm volatile("s_waitcnt vmcnt(0)" ::: "memory");
    }
  }
  __syncthreads();
}

#ifndef DIS
#define DIS 0
#endif
#ifndef PROBE_MASK
#define PROBE_MASK 0
#endif
constexpr int LDS_BYTES = 65536;
constexpr int PH_PER_LAYER = 10;
constexpr int NPHASES = 1 + DEPTH * PH_PER_LAYER;

__global__ void __launch_bounds__(256, 2) mk(Params p, int ph_lo, int ph_hi, int coop) {
  __shared__ __attribute__((aligned(16))) unsigned char smem[LDS_BYTES];
  __shared__ uint4 xb_words;
  cg::grid_group grid = cg::this_grid();
  if (coop == 2) grid.sync();
  const int G = gridDim.x, b = blockIdx.x;
  if (threadIdx.x == 0) xb_words = make_uint4(0u, 0u, 0u, 0u);
  __syncthreads();
  XcdBarrier xb = xcd_barrier_post((unsigned*)(p.ws + OFF_BAR), (volatile LAS unsigned*)&xb_words);
#if PROBE_MASK
  unsigned long long tprev = __builtin_amdgcn_s_memrealtime(), tacc = 0ull;
#endif
  for (int ph = ph_lo; ph < ph_hi; ++ph) {
    if (coop && ph > ph_lo) {
      xcd_barrier(xb);
#if PROBE_MASK
      { const unsigned long long tn = __builtin_amdgcn_s_memrealtime(); const int pp = ph - 1; const int kind = pp == 0 ? 10 : (pp - 1) % PH_PER_LAYER;
        if ((PROBE_MASK >> kind) & 1) tacc += tn - tprev; tprev = tn; }
#endif
    }
    if (ph == 0) {
      for (int i = b * 256 + opaque_tid(); i < LCTX * D / 4; i += G * 256) ((f32x4*)(p.ws + OFF_XC))[i] = ((const f32x4*)p.ctx)[i];
      for (int t = b; t < MOD_TASKS + 16; t += G) {
        if (t < MOD_TASKS) { if (!(DIS & 1)) mod_task(p, t, smem); }
        else rope_task(p, t - MOD_TASKS);
      }
      continue;
    }
    const int l = (ph - 1) / PH_PER_LAYER, s = (ph - 1) % PH_PER_LAYER;
    const bool last = l == DEPTH - 1;
    const float* xlat = l == 0 ? p.x : p.out;
    const float* xctx = (const float*)(p.ws + OFF_XC);
    const int ntm = last ? (NTOK / 128) : (R / 128);
    switch (s) {
      case 0: {
        const int ncv = CV_TOTAL;
        for (int t = b; t < R / 16 + ncv; t += G) {
          if (t < R / 16) norm_task(p, l, t, 0, xlat, xctx);
          else { if (!(DIS & 2)) convert_task(p, l, t - R / 16, smem); }
        }
      } break;
      case 1: if (!(DIS & 4)) phase_gemm_in(p, l, smem); break;
      case 2: case 3: case 4: {
        if (s == 4 && !last) { f32x4* y32 = (f32x4*)(p.ws + OFF_Y32); for (int i = b * 256 + opaque_tid(); i < LCTX * D / 4; i += G * 256) y32[i] = (f32x4){0.f, 0.f, 0.f, 0.f}; }
        const int nattn_all = (last ? NTOK / 128 : R / 128) * 16;
        const int nfirst = (s == 2) ? NCH * 4 : (s == 3) ? G2_TASKS : (last ? 256 : NCH) * 4;
        const int p4 = nattn_all - ATTN_P2 - ATTN_P3;
        const int a_lo = (s == 2) ? 0 : (s == 3) ? ATTN_P2 : ATTN_P2 + ATTN_P3;
        const int na = (s == 2) ? ATTN_P2 : (s == 3) ? ATTN_P3 : p4;
        const int tstride = (s == 3 && G == 512) ? (b < 256 ? (1 << 28) : 256) : G;
        for (int t = b; t < nfirst + na; t += tstride) {
          if (t < nfirst) {
            if (s == 2) gla_g1_task(p, l, t >> 2, t & 3, smem);
            else if (s == 3) gla_g2_task(p, t);
            else gla_g3_task(p, l, t >> 2, t & 3, smem);
          } else { const int a = a_lo + (t - nfirst); attn_task(p, l, a >> 4, a & 15, smem); }
        }
      } break;
      case 5: if (!(DIS & 128)) { phase_gemm<0>(p, l, NTOK / 128, nullptr, 0, nullptr, D, 8, 0, nullptr, nullptr, smem); if (!last) phase_merge_ctx(p, smem); } break;
      case 6: if (!(DIS & 256)) phase_gemm<1>(p, l, ntm, (const bf16_t*)(p.ws + OFF_H), D, (const bf16_t*)(p.ws + OFF_WO), D, 8, 2, xlat, xctx, smem); break;
      case 7: for (int t = b; t < ntm * 8; t += G) norm_task(p, l, t, 1, p.out, (const float*)(p.ws + OFF_XC)); break;
      case 8: if (!(DIS & 512)) phase_gemm<2>(p, l, ntm, (const bf16_t*)(p.ws + OFF_H), D, (const bf16_t*)(p.ws + OFF_WF1), D, 32, 0, nullptr, nullptr, smem); break;
      case 9: if (!(DIS & 256)) phase_gemm<1>(p, l, ntm, (const bf16_t*)(p.ws + OFF_Z), DFF, (const bf16_t*)(p.ws + OFF_WF2), DFF, 8, 5, p.out, (const float*)(p.ws + OFF_XC), smem); break;
    }
  }
#if PROBE_MASK
  if (b == 0) {
    { const unsigned long long tn = __builtin_amdgcn_s_memrealtime(); if ((PROBE_MASK >> 9) & 1) tacc += tn - tprev; tprev = tn; }
    const unsigned long long t0 = __builtin_amdgcn_s_memrealtime();
    while (__builtin_amdgcn_s_memrealtime() - t0 < 4ull * tacc) __builtin_amdgcn_s_sleep(8);
  }
#endif
}

#ifndef MULTI_LAUNCH
#define MULTI_LAUNCH 0
#endif

extern "C" void kernel_launch(void* const* d_in, const int* in_sizes, int n_in, void* d_out, int out_size,
                              void* d_ws, size_t ws_size, hipStream_t stream) {
  static int grid_blocks = 0;
  if (!grid_blocks) {
    int dev = 0, cus = 0, per_cu = 0;
    (void)hipGetDevice(&dev);
    (void)hipDeviceGetAttribute(&cus, hipDeviceAttributeMultiprocessorCount, dev);
    (void)hipOccupancyMaxActiveBlocksPerMultiprocessor(&per_cu, mk, 256, 0);
    if (per_cu > 2) per_cu = 2;
    if (per_cu < 1) per_cu = 1;
    grid_blocks = cus * per_cu;
  }
  if (ws_size < WS_NEED) { fprintf(stderr, "workspace too small: %zu < %zu\n", ws_size, (size_t)WS_NEED); return; }
  Params p{};
  const float** f = (const float**)&p;
  for (int i = 0; i < 20; ++i) f[i] = (const float*)d_in[i];
  p.out = (float*)d_out;
  p.ws = (unsigned char*)d_ws;
  (void)hipMemsetAsync((unsigned char*)d_ws + OFF_BAR, 0, XCD_BAR_WORDS * 4, stream);
#if MULTI_LAUNCH
  for (int ph = 0; ph < NPHASES; ++ph) {
    int lo = ph, hi = ph + 1, coop = 0;
    hipLaunchKernelGGL(mk, dim3(grid_blocks), dim3(256), 0, stream, p, lo, hi, coop);
  }
#else
  int lo = 0, hi = NPHASES, coop = 1;
  void* args[] = {&p, &lo, &hi, &coop};
  hipError_t e = hipLaunchCooperativeKernel((void*)mk, dim3(grid_blocks), dim3(256), args, 0, stream);
  if (e != hipSuccess) fprintf(stderr, "cooperative launch failed: %s (grid %d)\n", hipGetErrorString(e), grid_blocks);
#endif
}
```

```cpp
#include <hip/hip_runtime.h>
#include <hip/hip_cooperative_groups.h>
#include <cstdio>
#include <cstdint>
namespace cg = cooperative_groups;

typedef unsigned short bf16_t;
typedef short bf16x8 __attribute__((ext_vector_type(8)));
typedef float f32x4 __attribute__((ext_vector_type(4)));
typedef unsigned u32x2 __attribute__((ext_vector_type(2)));
typedef unsigned u32x4 __attribute__((ext_vector_type(4)));

constexpr int NTOK = 16384, LCTX = 256, R = NTOK + LCTX, D = 1024, DFF = 4096, DEPTH = 4;
constexpr int D_IN_SRC = 6688;
constexpr int ZLD = 5376;
constexpr int ZQ = 0, ZK = 1024, ZGQ = 1280, ZGK = 1792, ZGR = 2304, ZGA = 3328, ZGB = 4352;
constexpr int WIN_ROWS = 6784;
constexpr int NCH = R / 64;
constexpr float EPS = 1e-6f;
constexpr float LOG2E = 1.4426950408889634f;

constexpr size_t al256(size_t x) { return (x + 255) & ~(size_t)255; }
constexpr size_t OFF_WIN = 0;
constexpr size_t OFF_WBA = OFF_WIN + al256((size_t)WIN_ROWS * D * 2);
constexpr size_t OFF_WBG = OFF_WBA + al256((size_t)D * D * 2);
constexpr size_t OFF_WO  = OFF_WBG + al256((size_t)D * D * 2);
constexpr size_t OFF_WF1 = OFF_WO  + al256((size_t)D * D * 2);
constexpr size_t OFF_WF2 = OFF_WF1 + al256((size_t)DFF * D * 2);
constexpr size_t OFF_H   = OFF_WF2 + al256((size_t)DFF * D * 2);
constexpr size_t OFF_Z   = OFF_H   + al256((size_t)R * D * 2);
constexpr size_t OFF_VT  = OFF_Z   + al256((size_t)R * ZLD * 2);
constexpr size_t OFF_GVT = OFF_VT  + al256((size_t)256 * R * 2);
constexpr size_t OFF_ST  = OFF_GVT + al256((size_t)1024 * R * 2);
constexpr size_t OFF_GA  = OFF_ST  + al256((size_t)2 * NCH * 4 * 256 * 128 * 2);
constexpr size_t OFF_DL  = OFF_GA  + al256((size_t)R * 32 * 4);
constexpr size_t OFF_MOD = OFF_DL  + al256((size_t)2 * NCH * 4 * 128 * 4);
constexpr size_t OFF_XC  = OFF_MOD + al256((size_t)DEPTH * 2 * 6 * D * 4);
constexpr size_t OFF_ROPE = OFF_XC + al256((size_t)LCTX * D * 4);
constexpr size_t OFF_BAR = OFF_ROPE + al256((size_t)256 * 16 * 8);
constexpr size_t OFF_MODP = OFF_BAR + al256((size_t)3456 * 4);
constexpr size_t WS_NEED = OFF_MODP;

struct Params {
  const float *x, *c, *ctx, *c_ctx, *w_mod, *b_mod, *g_norm1, *w_in, *q_gain, *k_gain, *sink, *w_decay, *b_decay,
      *gla_gain, *w_ba, *w_bg, *w_out, *g_norm2, *w_ff1, *w_ff2;
  float* out;
  unsigned char* ws;
};

#define LAS __attribute__((address_space(3)))
__device__ __forceinline__ int opaque_tid() { int t = threadIdx.x; asm volatile("" : "+v"(t)); return t; }
__device__ __forceinline__ float bf2f(unsigned h) { return __uint_as_float(h << 16); }
__device__ __forceinline__ unsigned cvt_pk(float lo, float hi) { unsigned r; asm("v_cvt_pk_bf16_f32 %0, %1, %2" : "=v"(r) : "v"(lo), "v"(hi)); return r; }
__device__ __forceinline__ bf16_t f2bf(float f) { return (bf16_t)(cvt_pk(f, 0.f) & 0xffffu); }
__device__ __forceinline__ float bflo(unsigned u) { return __uint_as_float(u << 16); }
__device__ __forceinline__ float bfhi(unsigned u) { return __uint_as_float(u & 0xffff0000u); }
__device__ __forceinline__ float sigmoidf_(float x) { return 1.0f / (1.0f + __expf(-x)); }
__device__ __forceinline__ float siluf_(float x) { return x / (1.0f + __expf(-x)); }
__device__ __forceinline__ f32x4 mfma16(bf16x8 a, bf16x8 b, f32x4 c) { return __builtin_amdgcn_mfma_f32_16x16x32_bf16(a, b, c, 0, 0, 0); }

template <bool SWAP>
__device__ __forceinline__ void gemm_step(const unsigned char* __restrict__ rd, unsigned char* __restrict__ wr, bool refill,
                                          const bf16_t* __restrict__ ga, const bf16_t* __restrict__ gb, size_t a64, size_t b64,
                                          int aoff, int boff, f32x4 (&acc)[4][4]) {
  if (refill) {
    __builtin_amdgcn_global_load_lds((const unsigned*)(ga), (LAS unsigned*)(wr), 16, 0, 0);
    __builtin_amdgcn_global_load_lds((const unsigned*)(ga + a64), (LAS unsigned*)(wr + 4096), 16, 0, 0);
    __builtin_amdgcn_global_load_lds((const unsigned*)(gb), (LAS unsigned*)(wr + 8192), 16, 0, 0);
    __builtin_amdgcn_global_load_lds((const unsigned*)(gb + b64), (LAS unsigned*)(wr + 12288), 16, 0, 0);
  }
  bf16x8 af[4], bfv[4];
  const unsigned ra = (unsigned)(size_t)(const LAS unsigned char*)rd + (unsigned)aoff, rb = (unsigned)(size_t)(const LAS unsigned char*)rd + (unsigned)boff;
  asm volatile("ds_read_b128 %0, %1" : "=v"(af[0]) : "v"(ra));
  asm volatile("ds_read_b128 %0, %1" : "=v"(bfv[0]) : "v"(rb));
  asm volatile("ds_read_b128 %0, %1 offset:1024" : "=v"(af[1]) : "v"(ra));
  asm volatile("ds_read_b128 %0, %1 offset:1024" : "=v"(bfv[1]) : "v"(rb));
  asm volatile("ds_read_b128 %0, %1 offset:2048" : "=v"(af[2]) : "v"(ra));
  asm volatile("ds_read_b128 %0, %1 offset:2048" : "=v"(bfv[2]) : "v"(rb));
  asm volatile("ds_read_b128 %0, %1 offset:3072" : "=v"(af[3]) : "v"(ra));
  asm volatile("ds_read_b128 %0, %1 offset:3072" : "=v"(bfv[3]) : "v"(rb));
  asm volatile("s_waitcnt lgkmcnt(0)" : "+v"(af[0]), "+v"(af[1]), "+v"(af[2]), "+v"(af[3]), "+v"(bfv[0]), "+v"(bfv[1]), "+v"(bfv[2]), "+v"(bfv[3]));
#pragma unroll
  for (int mi = 0; mi < 4; ++mi)
#pragma unroll
    for (int ni = 0; ni < 4; ++ni)
      acc[mi][ni] = SWAP ? mfma16(bfv[ni], af[mi], acc[mi][ni]) : mfma16(af[mi], bfv[ni], acc[mi][ni]);
}

struct GNext { const bf16_t* A; const bf16_t* B; int lda, ldb; bool has; };
template <bool SWAP>
__device__ __forceinline__ void gemm_core(const bf16_t* __restrict__ A, int lda, const bf16_t* __restrict__ B, int ldb, int K,
                                          f32x4 (&acc)[4][4], unsigned char* smem, bool prefetched, const GNext nx) {
  const int tid = opaque_tid(), lane = tid & 63, wid = tid >> 6, wr = wid >> 1, wc = wid & 1, x = lane & 15, quad = lane >> 4;
  const int nk = K >> 5;
  const int lrow = tid >> 2, gch = (tid & 3) ^ ((0x78 >> (2 * ((tid >> 4) & 3))) & 3);
  const bf16_t* ga = A + (size_t)lrow * lda + gch * 8;
  const bf16_t* gb = B + (size_t)lrow * ldb + gch * 8;
  const size_t a64 = (size_t)64 * lda, b64 = (size_t)64 * ldb;
  unsigned char* sdst = smem + tid * 16;
#define GC_PAIR(k_) do { unsigned char* _d0 = sdst + ((k_) & 3) * 16384; unsigned char* _d1 = sdst + (((k_) + 1) & 3) * 16384; \
    const bf16_t* _pa = ga + (k_) * 32; const bf16_t* _pb = gb + (k_) * 32; \
    __builtin_amdgcn_global_load_lds((const unsigned*)(_pa), (LAS unsigned*)(_d0), 16, 0, 0); \
    __builtin_amdgcn_global_load_lds((const unsigned*)(_pa + 32), (LAS unsigned*)(_d1), 16, 0, 0); \
    __builtin_amdgcn_global_load_lds((const unsigned*)(_pa + a64), (LAS unsigned*)(_d0 + 4096), 16, 0, 0); \
    __builtin_amdgcn_global_load_lds((const unsigned*)(_pa + a64 + 32), (LAS unsigned*)(_d1 + 4096), 16, 0, 0); \
    __builtin_amdgcn_global_load_lds((const unsigned*)(_pb), (LAS unsigned*)(_d0 + 8192), 16, 0, 0); \
    __builtin_amdgcn_global_load_lds((const unsigned*)(_pb + 32), (LAS unsigned*)(_d1 + 8192), 16, 0, 0); \
    __builtin_amdgcn_global_load_lds((const unsigned*)(_pb + b64), (LAS unsigned*)(_d0 + 12288), 16, 0, 0); \
    __builtin_amdgcn_global_load_lds((const unsigned*)(_pb + b64 + 32), (LAS unsigned*)(_d1 + 12288), 16, 0, 0); } while (0)
  if (!prefetched) {
    __syncthreads();
    GC_PAIR(0);
  }
  const int rsw = (quad ^ ((0x78 >> (2 * ((x >> 2) & 3))) & 3)) << 4;
  const int aoff = (wr * 64 + x) * 64 + rsw, boff = 8192 + (wc * 64 + x) * 64 + rsw;
  for (int kt = 0; kt < nk; kt += 2) {
    asm volatile("s_waitcnt vmcnt(0)" ::: "memory");
    __builtin_amdgcn_s_barrier();
    asm volatile("" ::: "memory");
    if (kt + 2 < nk) GC_PAIR(kt + 2);
    else if (nx.has) {
      const bf16_t* na = nx.A + (size_t)lrow * nx.lda + gch * 8;
      const bf16_t* nb = nx.B + (size_t)lrow * nx.ldb + gch * 8;
      const size_t na64 = (size_t)64 * nx.lda, nb64 = (size_t)64 * nx.ldb;
      unsigned char* d0 = sdst; unsigned char* d1 = sdst + 16384;
      __builtin_amdgcn_global_load_lds((const unsigned*)(na), (LAS unsigned*)(d0), 16, 0, 0);
      __builtin_amdgcn_global_load_lds((const unsigned*)(na + 32), (LAS unsigned*)(d1), 16, 0, 0);
      __builtin_amdgcn_global_load_lds((const unsigned*)(na + na64), (LAS unsigned*)(d0 + 4096), 16, 0, 0);
      __builtin_amdgcn_global_load_lds((const unsigned*)(na + na64 + 32), (LAS unsigned*)(d1 + 4096), 16, 0, 0);
      __builtin_amdgcn_global_load_lds((const unsigned*)(nb), (LAS unsigned*)(d0 + 8192), 16, 0, 0);
      __builtin_amdgcn_global_load_lds((const unsigned*)(nb + 32), (LAS unsigned*)(d1 + 8192), 16, 0, 0);
      __builtin_amdgcn_global_load_lds((const unsigned*)(nb + nb64), (LAS unsigned*)(d0 + 12288), 16, 0, 0);
      __builtin_amdgcn_global_load_lds((const unsigned*)(nb + nb64 + 32), (LAS unsigned*)(d1 + 12288), 16, 0, 0);
    }
    gemm_step<SWAP>(smem + (kt & 3) * 16384, sdst, false, ga, gb, a64, b64, aoff, boff, acc);
    asm volatile("" ::: "memory");
    gemm_step<SWAP>(smem + ((kt + 1) & 3) * 16384, sdst, false, ga, gb, a64, b64, aoff, boff, acc);
    asm volatile("" ::: "memory");
  }
#undef GC_PAIR
}

__device__ __forceinline__ void zero_acc(f32x4 (&acc)[4][4]) {
#pragma unroll
  for (int i = 0; i < 4; ++i)
#pragma unroll
    for (int j = 0; j < 4; ++j) acc[i][j] = (f32x4){0.f, 0.f, 0.f, 0.f};
}

__device__ __forceinline__ void store_tile_bf16(const u32x2 (&v)[4][4], bf16_t* gbase, size_t ld, unsigned char* smem, int wid, int lane, unsigned lds_ofs = 32768u) {
  const int x = lane & 15, quad = lane >> 4;
  const unsigned sw = (unsigned)(size_t)(const LAS unsigned char*)smem + lds_ofs + (unsigned)wid * 4608u;
  const unsigned wa = sw + (unsigned)(x * 144 + quad * 8);
  const unsigned rr = sw + (unsigned)((lane >> 3) * 144 + (lane & 7) * 16);
  __builtin_amdgcn_s_barrier();
  asm volatile("" ::: "memory");
#pragma unroll
  for (int half = 0; half < 2; ++half) {
    if (half == 1) asm volatile("s_waitcnt lgkmcnt(0)" ::: "memory");
#pragma unroll
    for (int m2 = 0; m2 < 2; ++m2) {
      asm volatile("ds_write_b64 %0, %1" :: "v"(wa + m2 * 2304), "v"(v[2 * half + m2][0]) : "memory");
      asm volatile("ds_write_b64 %0, %1 offset:32" :: "v"(wa + m2 * 2304), "v"(v[2 * half + m2][1]) : "memory");
      asm volatile("ds_write_b64 %0, %1 offset:64" :: "v"(wa + m2 * 2304), "v"(v[2 * half + m2][2]) : "memory");
      asm volatile("ds_write_b64 %0, %1 offset:96" :: "v"(wa + m2 * 2304), "v"(v[2 * half + m2][3]) : "memory");
    }
    u32x4 o0, o1, o2, o3;
    asm volatile("ds_read_b128 %0, %1" : "=v"(o0) : "v"(rr) : "memory");
    asm volatile("ds_read_b128 %0, %1 offset:1152" : "=v"(o1) : "v"(rr) : "memory");
    asm volatile("ds_read_b128 %0, %1 offset:2304" : "=v"(o2) : "v"(rr) : "memory");
    asm volatile("ds_read_b128 %0, %1 offset:3456" : "=v"(o3) : "v"(rr) : "memory");
    asm volatile("s_waitcnt lgkmcnt(0)" : "+v"(o0), "+v"(o1), "+v"(o2), "+v"(o3));
    bf16_t* g = gbase + (size_t)(half * 32 + (lane >> 3)) * ld + (lane & 7) * 8;
    *(u32x4*)(g) = o0;
    *(u32x4*)(g + 8 * ld) = o1;
    *(u32x4*)(g + 16 * ld) = o2;
    *(u32x4*)(g + 24 * ld) = o3;
  }
}

__device__ __forceinline__ void resid_tile_f32(const f32x4 (&upd)[4][4], const float* src, float* dst, size_t ld, unsigned char* smem, int wid, int lane) {
  const int x = lane & 15, quad = lane >> 4;
  const unsigned sw = (unsigned)(size_t)(const LAS unsigned char*)smem + 32768u + (unsigned)wid * 4608u;
  const unsigned wa = sw + (unsigned)(x * 272 + quad * 16);
  const unsigned rr = sw + (unsigned)((lane >> 4) * 272 + (lane & 15) * 16);
  __builtin_amdgcn_s_barrier();
  asm volatile("" ::: "memory");
#pragma unroll
  for (int mi = 0; mi < 4; ++mi) {
    if (mi > 0) asm volatile("s_waitcnt lgkmcnt(0)" ::: "memory");
    asm volatile("ds_write_b128 %0, %1" :: "v"(wa), "v"(upd[mi][0]) : "memory");
    asm volatile("ds_write_b128 %0, %1 offset:64" :: "v"(wa), "v"(upd[mi][1]) : "memory");
    asm volatile("ds_write_b128 %0, %1 offset:128" :: "v"(wa), "v"(upd[mi][2]) : "memory");
    asm volatile("ds_write_b128 %0, %1 offset:192" :: "v"(wa), "v"(upd[mi][3]) : "memory");
    f32x4 o0, o1, o2, o3;
    asm volatile("ds_read_b128 %0, %1" : "=v"(o0) : "v"(rr) : "memory");
    asm volatile("ds_read_b128 %0, %1 offset:1088" : "=v"(o1) : "v"(rr) : "memory");
    asm volatile("ds_read_b128 %0, %1 offset:2176" : "=v"(o2) : "v"(rr) : "memory");
    asm volatile("ds_read_b128 %0, %1 offset:3264" : "=v"(o3) : "v"(rr) : "memory");
    const size_t go = (size_t)(mi * 16 + (lane >> 4)) * ld + (lane & 15) * 4;
    const f32x4 x0 = *(const f32x4*)(src + go), x1 = *(const f32x4*)(src + go + 4 * ld), x2 = *(const f32x4*)(src + go + 8 * ld), x3 = *(const f32x4*)(src + go + 12 * ld);
    asm volatile("s_waitcnt lgkmcnt(0)" : "+v"(o0), "+v"(o1), "+v"(o2), "+v"(o3));
    *(f32x4*)(dst + go) = x0 + o0;
    *(f32x4*)(dst + go + 4 * ld) = x1 + o1;
    *(f32x4*)(dst + go + 8 * ld) = x2 + o2;
    *(f32x4*)(dst + go + 12 * ld) = x3 + o3;
  }
}

__device__ __forceinline__ int gemm_bid() { const int b = blockIdx.x; return (gridDim.x == 512) ? ((b & 63) * 8 + (b >> 6)) : b; }
__device__ __forceinline__ void tile_map(int t, int ntm, int ntn, int& tm, int& tn) {
  const int per = 8 * ntn, grp = t / per, rem = t - grp * per;
  const int left = ntm - grp * 8, gsz = left < 8 ? left : 8;
  const int nblk = (gsz == 8) ? (ntn >> 3) * 64 : 0;
  if (rem < nblk) { const int cb = rem >> 6, r64 = rem & 63; tm = grp * 8 + (r64 >> 3); tn = cb * 8 + (r64 & 7); }
  else { const int r2 = rem - nblk; tm = grp * 8 + r2 % gsz; tn = (nblk >> 3) + r2 / gsz; }
}

__device__ void phase_gemm_in(const Params& p, int l, unsigned char* smem) {
  const bf16_t* H = (const bf16_t*)(p.ws + OFF_H);
  const bf16_t* W = (const bf16_t*)(p.ws + OFF_WIN);
  bf16_t* Z = (bf16_t*)(p.ws + OFF_Z);
  bf16_t* VT = (bf16_t*)(p.ws + OFF_VT);
  bf16_t* GVT = (bf16_t*)(p.ws + OFF_GVT);
  float* GA = (float*)(p.ws + OFF_GA);
  const float* ROPE = (const float*)(p.ws + OFF_ROPE);
  const int tid = opaque_tid(), lane = tid & 63, wid = tid >> 6, wr = wid >> 1, wc = wid & 1, x = lane & 15, quad = lane >> 4;
  constexpr int NTN = 53, NTM = R / 128;
  for (int t = gemm_bid(); t < NTN * NTM; t += gridDim.x) {
    int tm, tn; tile_map(t, NTM, NTN, tm, tn);
    const int row0 = tm * 128;
    f32x4 acc[4][4];
    zero_acc(acc);
    const bf16_t* Ap = H + (size_t)row0 * D;
    const bf16_t* Bp = W + (size_t)tn * 128 * D;
    const bool pref = t != gemm_bid();
    GNext nx{nullptr, nullptr, D, D, false};
    { const int t2 = t + gridDim.x; if (t2 < NTN * NTM) { int tm2, tn2; tile_map(t2, NTM, NTN, tm2, tn2); nx.A = H + (size_t)tm2 * 128 * D; nx.B = W + (size_t)tn2 * 128 * D; nx.has = true; } }
    if (tn >= 42 && tn < 52) {
      gemm_core<false>(Ap, D, Bp, D, D, acc, smem, pref, nx);
      u32x2 pk[4][4];
#pragma unroll
      for (int ni = 0; ni < 4; ++ni)
#pragma unroll
        for (int mi = 0; mi < 4; ++mi) { pk[ni][mi].x = cvt_pk(acc[mi][ni][0], acc[mi][ni][1]); pk[ni][mi].y = cvt_pk(acc[mi][ni][2], acc[mi][ni][3]); }
      const int n0 = (tn - 42) * 128 + wc * 64;
      bf16_t* tb = (n0 < 256) ? (VT + (size_t)n0 * R) : (GVT + (size_t)(n0 - 256) * R);
      store_tile_bf16(pk, tb + row0 + wr * 64, R, smem, wid, lane);
    } else {
      gemm_core<true>(Ap, D, Bp, D, D, acc, smem, pref, nx);
      if (tn == 52) {
        if (wc == 0) {
#pragma unroll
          for (int mi = 0; mi < 4; ++mi) {
            const int row = row0 + wr * 64 + mi * 16 + x;
#pragma unroll
            for (int ni = 0; ni < 2; ++ni) *(f32x4*)(GA + (size_t)row * 32 + ni * 16 + quad * 4) = acc[mi][ni];
          }
        }
      } else if (tn < 10) {
        const bool isq = tn < 8;
        const float* gain = (isq ? p.q_gain : p.k_gain) + l * 64;
        f32x4 gv[4];
#pragma unroll
        for (int ni = 0; ni < 4; ++ni) gv[ni] = *(const f32x4*)(gain + ni * 16 + quad * 4);
        const float post = isq ? (0.125f * LOG2E) : 1.0f;
        u32x2 pk[4][4];
#pragma unroll
        for (int mi = 0; mi < 4; ++mi) {
          const int row = row0 + wr * 64 + mi * 16 + x;
          float ss = 0.f;
#pragma unroll
          for (int ni = 0; ni < 4; ++ni)
#pragma unroll
            for (int r = 0; r < 4; ++r) ss += acc[mi][ni][r] * acc[mi][ni][r];
          ss += __shfl_xor(ss, 16); ss += __shfl_xor(ss, 32);
          const float rstd = rsqrtf(ss * (1.0f / 64.0f) + EPS);
          f32x4 v[4];
#pragma unroll
          for (int ni = 0; ni < 4; ++ni) v[ni] = acc[mi][ni] * rstd * gv[ni];
          if (row < NTOK) {
            const int prow = row >> 6, pcol = row & 63;
            const float* t0 = ROPE + ((size_t)prow * 16 + quad * 4) * 2;
            const float* t1 = ROPE + ((size_t)pcol * 16 + quad * 4) * 2;
            const f32x4 a0 = *(const f32x4*)t0, a1 = *(const f32x4*)(t0 + 4), b0 = *(const f32x4*)t1, b1 = *(const f32x4*)(t1 + 4);
            const float cr[4] = {a0[0], a0[2], a1[0], a1[2]}, sr[4] = {a0[1], a0[3], a1[1], a1[3]};
            const float cc[4] = {b0[0], b0[2], b1[0], b1[2]}, sc[4] = {b0[1], b0[3], b1[1], b1[3]};
#pragma unroll
            for (int r = 0; r < 4; ++r) {
              const float x1 = v[0][r], x2 = v[1][r];
              v[0][r] = x1 * cr[r] - x2 * sr[r]; v[1][r] = x2 * cr[r] + x1 * sr[r];
              const float y1 = v[2][r], y2 = v[3][r];
              v[2][r] = y1 * cc[r] - y2 * sc[r]; v[3][r] = y2 * cc[r] + y1 * sc[r];
            }
          }
#pragma unroll
          for (int ni = 0; ni < 4; ++ni) { pk[mi][ni].x = cvt_pk(v[ni][0] * post, v[ni][1] * post); pk[mi][ni].y = cvt_pk(v[ni][2] * post, v[ni][3] * post); }
        }
        store_tile_bf16(pk, Z + (size_t)(row0 + wr * 64) * ZLD + tn * 128 + wc * 64, ZLD, smem, wid, lane);
      } else {
        u32x2 pk[4][4];
#pragma unroll
        for (int mi = 0; mi < 4; ++mi)
#pragma unroll
          for (int ni = 0; ni < 4; ++ni) { pk[mi][ni].x = cvt_pk(acc[mi][ni][0], acc[mi][ni][1]); pk[mi][ni].y = cvt_pk(acc[mi][ni][2], acc[mi][ni][3]); }
        store_tile_bf16(pk, Z + (size_t)(row0 + wr * 64) * ZLD + tn * 128 + wc * 64, ZLD, smem, wid, lane);
      }
    }
  }
}

template <int MODE>
__device__ void phase_gemm(const Params& p, int l, int ntm, const bf16_t* A, int lda, const bf16_t* W, int K, int ntn,
                           int gate_idx, const float* xsrc_lat, const float* xsrc_ctx, unsigned char* smem) {
  const int tid = opaque_tid(), lane = tid & 63, wid = tid >> 6, wr = wid >> 1, wc = wid & 1, x = lane & 15, quad = lane >> 4;
  bf16_t* Z = (bf16_t*)(p.ws + OFF_Z);
  bf16_t* Hb = (bf16_t*)(p.ws + OFF_H);
  float* XC = (float*)(p.ws + OFF_XC);
  const float* MOD = (const float*)(p.ws + OFF_MOD);
  const int KS = (MODE == 1 && ntm > NTOK / 128) ? (K == D ? 4 : 8) : 1;
  const int ntm_full = (KS > 1) ? NTOK / 128 : ntm;
  const int nfull = ntm_full * ntn, nunits = (KS > 1) ? 16 * KS : 0;
  auto decode = [&](int tt, int& row0_, int& col0_, int& kofs_, int& klen_, bool& split_) {
    int tm, tn; kofs_ = 0; klen_ = K; split_ = false;
    if (tt < nfull) tile_map(tt, ntm_full, ntn, tm, tn);
    else { const int u = tt - nfull, ks = u >> 4, r = u & 15; tm = NTOK / 128 + (r & 1); tn = r >> 1; klen_ = K / KS; kofs_ = ks * klen_; split_ = true; }
    row0_ = tm * 128; col0_ = tn * 128;
  };
  for (int t = gemm_bid(); t < nfull + nunits; t += gridDim.x) {
    int row0, col0, kofs, klen; bool split;
    decode(t, row0, col0, kofs, klen, split);
    const bool pref = t != gemm_bid();
    GNext nx{nullptr, nullptr, 0, 0, false};
    { const int t2 = t + gridDim.x;
      if (t2 < nfull + nunits) {
        int r2, c2, ko2, kl2; bool sp2; decode(t2, r2, c2, ko2, kl2, sp2);
        if (MODE == 0) { nx.A = Z + (size_t)r2 * ZLD + ZQ; nx.lda = ZLD; nx.B = (const bf16_t*)(p.ws + OFF_WBA) + (size_t)c2 * D; nx.ldb = D; }
        else { nx.A = A + (size_t)r2 * lda + ko2; nx.lda = lda; nx.B = W + (size_t)c2 * K + ko2; nx.ldb = K; }
        nx.has = true;
      } }
    f32x4 acc[4][4];
    zero_acc(acc);
    if (MODE == 0) {
      { const GNext n2{Z + (size_t)row0 * ZLD + ZGR, (const bf16_t*)(p.ws + OFF_WBG) + (size_t)col0 * D, ZLD, D, true};
        gemm_core<true>(Z + (size_t)row0 * ZLD + ZQ, ZLD, (const bf16_t*)(p.ws + OFF_WBA) + (size_t)col0 * D, D, D, acc, smem, pref, n2); }
      u32x2 y1[4][4];
#pragma unroll
      for (int mi = 0; mi < 4; ++mi) {
        const int row = row0 + wr * 64 + mi * 16 + x;
        const bf16_t* g = Z + (size_t)row * ZLD + ZGA + col0 + wc * 64 + quad * 4;
#pragma unroll
        for (int ni = 0; ni < 4; ++ni) {
          const u32x2 gg = *(const u32x2*)(g + ni * 16);
          y1[mi][ni].x = cvt_pk(acc[mi][ni][0] * sigmoidf_(bflo(gg.x)), acc[mi][ni][1] * sigmoidf_(bfhi(gg.x)));
          y1[mi][ni].y = cvt_pk(acc[mi][ni][2] * sigmoidf_(bflo(gg.y)), acc[mi][ni][3] * sigmoidf_(bfhi(gg.y)));
        }
      }
      zero_acc(acc);
      gemm_core<true>(Z + (size_t)row0 * ZLD + ZGR, ZLD, (const bf16_t*)(p.ws + OFF_WBG) + (size_t)col0 * D, D, D, acc, smem, true, nx);
#pragma unroll
      for (int mi = 0; mi < 4; ++mi) {
        const int row = row0 + wr * 64 + mi * 16 + x;
        const bf16_t* g = Z + (size_t)row * ZLD + ZGB + col0 + wc * 64 + quad * 4;
#pragma unroll
        for (int ni = 0; ni < 4; ++ni) {
          const u32x2 gg = *(const u32x2*)(g + ni * 16);
          const float y0 = bflo(y1[mi][ni].x) + sigmoidf_(bflo(gg.x)) * acc[mi][ni][0];
          const float y1f = bfhi(y1[mi][ni].x) + sigmoidf_(bfhi(gg.x)) * acc[mi][ni][1];
          const float y2 = bflo(y1[mi][ni].y) + sigmoidf_(bflo(gg.y)) * acc[mi][ni][2];
          const float y3 = bfhi(y1[mi][ni].y) + sigmoidf_(bfhi(gg.y)) * acc[mi][ni][3];
          y1[mi][ni].x = cvt_pk(y0, y1f); y1[mi][ni].y = cvt_pk(y2, y3);
        }
      }
      store_tile_bf16(y1, Hb + (size_t)(row0 + wr * 64) * D + col0 + wc * 64, D, smem, wid, lane);
    } else {
      gemm_core<true>(A + (size_t)row0 * lda + kofs, lda, W + (size_t)col0 * K + kofs, K, klen, acc, smem, pref, nx);
      if (MODE == 1) {
        const bool isctx = row0 >= NTOK;
        const float* gt = MOD + ((size_t)(l * 2 + (isctx ? 1 : 0)) * 6 + gate_idx) * D + col0 + wc * 64 + quad * 4;
        f32x4 gv[4];
#pragma unroll
        for (int ni = 0; ni < 4; ++ni) gv[ni] = *(const f32x4*)(gt + ni * 16);
        if (split) {
#pragma unroll
          for (int mi = 0; mi < 4; ++mi) {
            const int row = row0 + wr * 64 + mi * 16 + x;
            float* dst = XC + (size_t)(row - NTOK) * D + col0 + wc * 64 + quad * 4;
#pragma unroll
            for (int ni = 0; ni < 4; ++ni) {
              const f32x4 v = gv[ni] * acc[mi][ni];
#pragma unroll
              for (int r = 0; r < 4; ++r) unsafeAtomicAdd(dst + ni * 16 + r, v[r]);
            }
          }
        } else {
#pragma unroll
          for (int mi = 0; mi < 4; ++mi)
#pragma unroll
            for (int ni = 0; ni < 4; ++ni) acc[mi][ni] = gv[ni] * acc[mi][ni];
          const size_t tofs = (size_t)(isctx ? row0 - NTOK + wr * 64 : row0 + wr * 64) * D + col0 + wc * 64;
          resid_tile_f32(acc, (isctx ? xsrc_ctx : xsrc_lat) + tofs, (isctx ? XC : p.out) + tofs, D, smem, wid, lane);
        }
      } else {
        bf16_t* U = Z;
        u32x2 pk[4][4];
#pragma unroll
        for (int mi = 0; mi < 4; ++mi)
#pragma unroll
          for (int ni = 0; ni < 4; ++ni) {
            f32x4 v = acc[mi][ni];
#pragma unroll
            for (int r = 0; r < 4; ++r) { const float a = fmaxf(v[r], 0.f); v[r] = a * a; }
            pk[mi][ni].x = cvt_pk(v[0], v[1]); pk[mi][ni].y = cvt_pk(v[2], v[3]);
          }
        store_tile_bf16(pk, U + (size_t)(row0 + wr * 64) * DFF + col0 + wc * 64, DFF, smem, wid, lane);
      }
    }
  }
}

__device__ __forceinline__ int win_src_col(int n) {
  if (n < 1280) return n;
  if (n < 1792) return 1536 + (n - 1280);
  if (n < 2304) return 2048 + (n - 1792);
  if (n < 3328) return 3584 + (n - 2304);
  if (n < 4352) return 4640 + (n - 3328);
  if (n < 5376) return 5664 + (n - 4352);
  if (n < 5632) return 1280 + (n - 5376);
  if (n < 6656) return 2560 + (n - 5632);
  if (n < 6688) return 4608 + (n - 6656);
  return -1;
}

__device__ __forceinline__ void convert_tile(const float* __restrict__ src, int ld_src, int k0, int sc0, int sc1, bf16_t* __restrict__ dst, int K, int n0,
                                             unsigned char* smem) {
  float* tile = (float*)smem;
  const int tid = opaque_tid();
  __syncthreads();
#pragma unroll
  for (int i = 0; i < 4; ++i) {
    const int k = (tid >> 4) + i * 16, c4 = (tid & 15) * 4;
    const int sc = (c4 < 32) ? sc0 : sc1;
    f32x4 v = (f32x4){0.f, 0.f, 0.f, 0.f};
    if (sc >= 0) v = *(const f32x4*)(src + (size_t)(k0 + k) * ld_src + sc + (c4 & 31));
    tile[k * 65 + c4 + 0] = v[0]; tile[k * 65 + c4 + 1] = v[1]; tile[k * 65 + c4 + 2] = v[2]; tile[k * 65 + c4 + 3] = v[3];
  }
  __syncthreads();
#pragma unroll
  for (int i = 0; i < 2; ++i) {
    const int id = tid + i * 256, n = id >> 3, kc = id & 7;
    u32x4 w;
    w.x = cvt_pk(tile[(kc * 8 + 0) * 65 + n], tile[(kc * 8 + 1) * 65 + n]);
    w.y = cvt_pk(tile[(kc * 8 + 2) * 65 + n], tile[(kc * 8 + 3) * 65 + n]);
    w.z = cvt_pk(tile[(kc * 8 + 4) * 65 + n], tile[(kc * 8 + 5) * 65 + n]);
    w.w = cvt_pk(tile[(kc * 8 + 6) * 65 + n], tile[(kc * 8 + 7) * 65 + n]);
    *(u32x4*)(dst + (size_t)(n0 + n) * K + k0 + kc * 8) = w;
  }
}

constexpr int CV_IN = (WIN_ROWS / 64) * (D / 64);
constexpr int CV_SQ = (D / 64) * (D / 64);
constexpr int CV_FF = (DFF / 64) * (D / 64);
constexpr int CV_TOTAL = CV_IN + 3 * CV_SQ + 2 * CV_FF;

__device__ void convert_task(const Params& p, int l, int t, unsigned char* smem) {
  if (t < CV_IN) {
    const int nt = t / 16, kt = t % 16, n0 = nt * 64;
    convert_tile(p.w_in + (size_t)l * D * D_IN_SRC, D_IN_SRC, kt * 64, win_src_col(n0), win_src_col(n0 + 32), (bf16_t*)(p.ws + OFF_WIN), D, n0, smem);
    return;
  }
  t -= CV_IN;
  if (t < 3 * CV_SQ) {
    const int which = t / CV_SQ, tt = t % CV_SQ, nt = tt / 16, kt = tt % 16, n0 = nt * 64;
    const float* src = (which == 0 ? p.w_ba : which == 1 ? p.w_bg : p.w_out) + (size_t)l * D * D;
    bf16_t* dst = (bf16_t*)(p.ws + (which == 0 ? OFF_WBA : which == 1 ? OFF_WBG : OFF_WO));
    convert_tile(src, D, kt * 64, n0, n0 + 32, dst, D, n0, smem);
    return;
  }
  t -= 3 * CV_SQ;
  if (t < CV_FF) {
    const int nt = t / 16, kt = t % 16, n0 = nt * 64;
    convert_tile(p.w_ff1 + (size_t)l * D * DFF, DFF, kt * 64, n0, n0 + 32, (bf16_t*)(p.ws + OFF_WF1), D, n0, smem);
    return;
  }
  t -= CV_FF;
  {
    const int nt = t / 64, kt = t % 64, n0 = nt * 64;
    convert_tile(p.w_ff2 + (size_t)l * DFF * D, D, kt * 64, n0, n0 + 32, (bf16_t*)(p.ws + OFF_WF2), DFF, n0, smem);
  }
}

constexpr int MOD_TASKS = DEPTH * 96;
__device__ void mod_task(const Params& p, int t, unsigned char* smem) {
  float* sc = (float*)smem;
  float* red = sc + 2 * D;
  const int tid = opaque_tid();
  __syncthreads();
  for (int i = tid; i < D; i += 256) { sc[i] = siluf_(p.c[i]); sc[D + i] = siluf_(p.c_ctx[i]); }
  __syncthreads();
  const int l = t / 96, col0 = (t % 96) * 64, kr = tid >> 4, cl = tid & 15;
  const float* w = p.w_mod + (size_t)l * D * 6 * D + col0 + cl * 4;
  f32x4 a0 = (f32x4){0.f, 0.f, 0.f, 0.f}, a1 = a0;
#pragma unroll 16
  for (int i = 0; i < 64; ++i) {
    const int k = kr + i * 16;
    const f32x4 wv = *(const f32x4*)(w + (size_t)k * 6 * D);
    a0 += wv * sc[k]; a1 += wv * sc[D + k];
  }
  *(f32x4*)(red + (kr * 16 + cl) * 8) = a0; *(f32x4*)(red + (kr * 16 + cl) * 8 + 4) = a1;
  __syncthreads();
  if (tid < 128) {
    const int c2 = tid >> 3, j = tid & 7;
    float sum = 0.f;
#pragma unroll
    for (int r = 0; r < 16; ++r) sum += red[(r * 16 + c2) * 8 + j];
    const int col = col0 + c2 * 4 + (j & 3);
    float* MOD = (float*)(p.ws + OFF_MOD);
    MOD[(size_t)(l * 2 + (j >> 2)) * 6 * D + col] = sum + p.b_mod[l * 6 * D + col];
  }
}
__device__ void rope_task(const Params& p, int t) {
  const int id = t * 256 + opaque_tid(), pos = id >> 4, i = id & 15;
  const double inv = exp2(-(double)i * (13.287712379549449 / 16.0));
  const double rev = (double)pos * inv * 0.15915494309189535;
  const float fr = (float)(rev - floor(rev));
  float* ROPE = (float*)(p.ws + OFF_ROPE);
  ROPE[id * 2 + 0] = __builtin_amdgcn_cosf(fr);
  ROPE[id * 2 + 1] = __builtin_amdgcn_sinf(fr);
}

__device__ void norm_task(const Params& p, int l, int t, int which, const float* xlat, const float* xctx) {
  const int tid = opaque_tid(), lane = tid & 63, wid = tid >> 6;
  const float* MOD = (const float*)(p.ws + OFF_MOD);
  bf16_t* H = (bf16_t*)(p.ws + OFF_H);
  const float* g = (which == 0 ? p.g_norm1 : p.g_norm2) + l * D;
  const bool isctx = t * 16 >= NTOK;
  const float* sh = MOD + ((size_t)(l * 2 + (isctx ? 1 : 0)) * 6 + which * 3 + 0) * D;
  const float* sc = sh + D;
  f32x4 gm[4], shv[4];
#pragma unroll
  for (int j = 0; j < 4; ++j) {
    const int c = j * 256 + lane * 4;
    const f32x4 gg = *(const f32x4*)(g + c), s = *(const f32x4*)(sc + c);
    gm[j] = gg * (s + 1.0f); shv[j] = *(const f32x4*)(sh + c);
  }
#pragma unroll
  for (int it = 0; it < 4; ++it) {
    const int row = t * 16 + it * 4 + wid;
    const float* xr = isctx ? (xctx + (size_t)(row - NTOK) * D) : (xlat + (size_t)row * D);
    f32x4 v[4];
    float ss = 0.f;
#pragma unroll
    for (int j = 0; j < 4; ++j) { v[j] = *(const f32x4*)(xr + j * 256 + lane * 4); ss += v[j][0] * v[j][0] + v[j][1] * v[j][1] + v[j][2] * v[j][2] + v[j][3] * v[j][3]; }
#pragma unroll
    for (int o = 32; o >= 1; o >>= 1) ss += __shfl_xor(ss, o);
    const float rstd = rsqrtf(ss * (1.0f / D) + EPS);
#pragma unroll
    for (int j = 0; j < 4; ++j) {
      const f32x4 h = v[j] * rstd * gm[j] + shv[j];
      u32x2 w; w.x = cvt_pk(h[0], h[1]); w.y = cvt_pk(h[2], h[3]);
      *(u32x2*)(H + (size_t)row * D + j * 256 + lane * 4) = w;
    }
  }
}

__device__ void attn_task(const Params& p, int l, int qb, int h, unsigned char* smem) {
  bf16_t* Z = (bf16_t*)(p.ws + OFF_Z);
  const bf16_t* VT = (const bf16_t*)(p.ws + OFF_VT);
  const int tid = opaque_tid(), lane = tid & 63, wid = tid >> 6, x = lane & 15, quad = lane >> 4;
  const int kh = h >> 2;
  const bool ctxq = qb >= (NTOK / 128);
  int lo = 0, nloc = 0;
  if (!ctxq) {
    lo = (qb - 1) * 128; if (lo < 0) lo = 0;
    int hi = (qb + 2) * 128; if (hi > NTOK) hi = NTOK;
    nloc = (hi - lo) >> 6;
  }
  const int ntiles = nloc + 4;
  unsigned char* sK = smem;
  unsigned char* sV = smem + 8192;
  bf16x8 qf[2][2];
#pragma unroll
  for (int qt = 0; qt < 2; ++qt)
#pragma unroll
    for (int kk = 0; kk < 2; ++kk)
      qf[qt][kk] = *(const bf16x8*)(Z + (size_t)(qb * 128 + wid * 32 + qt * 16 + x) * ZLD + ZQ + h * 64 + kk * 32 + quad * 8);
  const float sinkv = p.sink[l * 16 + h] * LOG2E;
  float mrun[2] = {sinkv, sinkv}, lrun[2];
  lrun[0] = lrun[1] = (quad == 0) ? 1.0f : 0.0f;
  f32x4 o[2][4];
#pragma unroll
  for (int qt = 0; qt < 2; ++qt)
#pragma unroll
    for (int dt = 0; dt < 4; ++dt) o[qt][dt] = (f32x4){0.f, 0.f, 0.f, 0.f};

  u32x4 rk[2], rv[2];
  auto gload = [&](int ti) {
    const int start = (ti < nloc) ? (lo + ti * 64) : (NTOK + (ti - nloc) * 64);
#pragma unroll
    for (int i = 0; i < 2; ++i) {
      const int id = tid + i * 256, rr = id >> 3, ch = id & 7;
      rk[i] = *(const u32x4*)(Z + (size_t)(start + rr) * ZLD + ZK + kh * 64 + ch * 8);
      rv[i] = *(const u32x4*)(VT + (size_t)(kh * 64 + rr) * R + start + ch * 8);
    }
  };
  gload(0);
  for (int ti = 0; ti < ntiles; ++ti) {
    __syncthreads();
#pragma unroll
    for (int i = 0; i < 2; ++i) {
      const int id = tid + i * 256, rr = id >> 3, ch = id & 7;
      *(u32x4*)(sK + rr * 128 + ((ch ^ (rr & 7)) << 4)) = rk[i];
      *(u32x4*)(sV + rr * 144 + ch * 16) = rv[i];
    }
    __syncthreads();
    const bool local = ti < nloc;
    const int start = local ? (lo + ti * 64) : 0;
    if (ti + 1 < ntiles) gload(ti + 1);
    f32x4 st[2][4];
#pragma unroll
    for (int t = 0; t < 4; ++t) {
      bf16x8 kf[2];
#pragma unroll
      for (int kk = 0; kk < 2; ++kk) { const int rr = t * 16 + x, ch = kk * 4 + quad; kf[kk] = *(const bf16x8*)(sK + rr * 128 + ((ch ^ (rr & 7)) << 4)); }
#pragma unroll
      for (int qt = 0; qt < 2; ++qt) {
        f32x4 a = (f32x4){0.f, 0.f, 0.f, 0.f};
        a = mfma16(kf[0], qf[qt][0], a);
        a = mfma16(kf[1], qf[qt][1], a);
        st[qt][t] = a;
      }
    }
    if (local) {
#pragma unroll
      for (int qt = 0; qt < 2; ++qt) {
        const int qpos = qb * 128 + wid * 32 + qt * 16 + x;
#pragma unroll
        for (int t = 0; t < 4; ++t)
#pragma unroll
          for (int r = 0; r < 4; ++r) {
            const int dd = qpos - (start + t * 16 + quad * 4 + r);
            if (dd > 128 || dd < -128) st[qt][t][r] = -1e30f;
          }
      }
    }
    bf16x8 pb[2][2];
#pragma unroll
    for (int qt = 0; qt < 2; ++qt) {
      float mx = st[qt][0][0];
#pragma unroll
      for (int t = 0; t < 4; ++t)
#pragma unroll
        for (int r = 0; r < 4; ++r) mx = fmaxf(mx, st[qt][t][r]);
      mx = fmaxf(mx, __shfl_xor(mx, 16)); mx = fmaxf(mx, __shfl_xor(mx, 32));
      const float mnew = fmaxf(mrun[qt], mx);
      const float alpha = __builtin_amdgcn_exp2f(mrun[qt] - mnew);
      mrun[qt] = mnew;
      float ps = 0.f;
#pragma unroll
      for (int t = 0; t < 4; ++t)
#pragma unroll
        for (int r = 0; r < 4; ++r) { const float e = __builtin_amdgcn_exp2f(st[qt][t][r] - mnew); st[qt][t][r] = e; ps += e; }
      lrun[qt] = lrun[qt] * alpha + ps;
#pragma unroll
      for (int dt = 0; dt < 4; ++dt) o[qt][dt] *= alpha;
#pragma unroll
      for (int hh = 0; hh < 2; ++hh) {
        u32x4 w;
        w.x = cvt_pk(st[qt][2 * hh][0], st[qt][2 * hh][1]); w.y = cvt_pk(st[qt][2 * hh][2], st[qt][2 * hh][3]);
        w.z = cvt_pk(st[qt][2 * hh + 1][0], st[qt][2 * hh + 1][1]); w.w = cvt_pk(st[qt][2 * hh + 1][2], st[qt][2 * hh + 1][3]);
        pb[qt][hh] = __builtin_bit_cast(bf16x8, w);
      }
    }
#pragma unroll
    for (int dt = 0; dt < 4; ++dt)
#pragma unroll
      for (int hh = 0; hh < 2; ++hh) {
        const unsigned char* vr = sV + (dt * 16 + x) * 144 + quad * 8;
        const u32x2 v0 = *(const u32x2*)(vr + (2 * hh) * 32), v1 = *(const u32x2*)(vr + (2 * hh + 1) * 32);
        u32x4 w; w.x = v0.x; w.y = v0.y; w.z = v1.x; w.w = v1.y;
        const bf16x8 va = __builtin_bit_cast(bf16x8, w);
#pragma unroll
        for (int qt = 0; qt < 2; ++qt) o[qt][dt] = mfma16(va, pb[qt][hh], o[qt][dt]);
      }
  }
  u32x2 opk[2][4];
#pragma unroll
  for (int qt = 0; qt < 2; ++qt) {
    float lt = lrun[qt];
    lt += __shfl_xor(lt, 16); lt += __shfl_xor(lt, 32);
    const float inv = 1.0f / lt;
#pragma unroll
    for (int dt = 0; dt < 4; ++dt) { opk[qt][dt].x = cvt_pk(o[qt][dt][0] * inv, o[qt][dt][1] * inv); opk[qt][dt].y = cvt_pk(o[qt][dt][2] * inv, o[qt][dt][3] * inv); }
  }
  {
    const unsigned sw = (unsigned)(size_t)(const LAS unsigned char*)smem + 32768u + (unsigned)wid * 4608u;
    const unsigned wa = sw + (unsigned)(x * 144 + quad * 8), rr = sw + (unsigned)((lane >> 3) * 144 + (lane & 7) * 16);
#pragma unroll
    for (int qt = 0; qt < 2; ++qt) {
      asm volatile("ds_write_b64 %0, %1" :: "v"(wa + qt * 2304), "v"(opk[qt][0]) : "memory");
      asm volatile("ds_write_b64 %0, %1 offset:32" :: "v"(wa + qt * 2304), "v"(opk[qt][1]) : "memory");
      asm volatile("ds_write_b64 %0, %1 offset:64" :: "v"(wa + qt * 2304), "v"(opk[qt][2]) : "memory");
      asm volatile("ds_write_b64 %0, %1 offset:96" :: "v"(wa + qt * 2304), "v"(opk[qt][3]) : "memory");
    }
    u32x4 o0, o1, o2, o3;
    asm volatile("ds_read_b128 %0, %1" : "=v"(o0) : "v"(rr) : "memory");
    asm volatile("ds_read_b128 %0, %1 offset:1152" : "=v"(o1) : "v"(rr) : "memory");
    asm volatile("ds_read_b128 %0, %1 offset:2304" : "=v"(o2) : "v"(rr) : "memory");
    asm volatile("ds_read_b128 %0, %1 offset:3456" : "=v"(o3) : "v"(rr) : "memory");
    asm volatile("s_waitcnt lgkmcnt(0)" : "+v"(o0), "+v"(o1), "+v"(o2), "+v"(o3));
    bf16_t* g = Z + (size_t)(qb * 128 + wid * 32 + (lane >> 3)) * ZLD + ZQ + h * 64 + (lane & 7) * 8;
    *(u32x4*)(g) = o0;
    *(u32x4*)(g + (size_t)8 * ZLD) = o1;
    *(u32x4*)(g + (size_t)16 * ZLD) = o2;
    *(u32x4*)(g + (size_t)24 * ZLD) = o3;
  }
}

__device__ __forceinline__ size_t st_index(int dir, int c, int h) { return ((size_t)(dir * NCH + c) * 4 + h) * (256 * 128); }

template <int DIR>
__device__ __forceinline__ float gla_g1_scan(const float* sga, const float (&w)[16], float bias, const u32x4 (&qrow)[8], const u32x4 (&krow)[8],
                                             bf16_t* qdst, bf16_t* kdst, int dld, bf16_t* skrow) {
  float run = 0.f;
#pragma nounroll
  for (int gg = 0; gg < 8; ++gg) {
    const int g = DIR ? 7 - gg : gg;
    u32x4 qg, kg;
    switch (g) {
      case 0: qg = qrow[0]; kg = krow[0]; break;
      case 1: qg = qrow[1]; kg = krow[1]; break;
      case 2: qg = qrow[2]; kg = krow[2]; break;
      case 3: qg = qrow[3]; kg = krow[3]; break;
      case 4: qg = qrow[4]; kg = krow[4]; break;
      case 5: qg = qrow[5]; kg = krow[5]; break;
      case 6: qg = qrow[6]; kg = krow[6]; break;
      default: qg = qrow[7]; kg = krow[7]; break;
    }
    unsigned kprev = 0;
#pragma unroll
    for (int j = 0; j < 8; ++j) {
      const int tl = DIR ? 7 - j : j;
      const int t = g * 8 + tl;
      const float* gr = sga + t * 32 + DIR * 16;
      const f32x4 g0 = *(const f32x4*)gr, g1 = *(const f32x4*)(gr + 4), g2 = *(const f32x4*)(gr + 8), g3 = *(const f32x4*)(gr + 12);
      float xg = bias;
      xg += g0[0] * w[0] + g0[1] * w[1] + g0[2] * w[2] + g0[3] * w[3];
      xg += g1[0] * w[4] + g1[1] * w[5] + g1[2] * w[6] + g1[3] * w[7];
      xg += g2[0] * w[8] + g2[1] * w[9] + g2[2] * w[10] + g2[3] * w[11];
      xg += g3[0] * w[12] + g3[1] * w[13] + g3[2] * w[14] + g3[3] * w[15];
      const float ls = fminf(xg, 0.f) - __logf(1.0f + __expf(-fabsf(xg)));
      run += ls * (1.0f / 16.0f);
      const unsigned qw = qg[tl >> 1], kw = kg[tl >> 1];
      const float qv = (tl & 1) ? bfhi(qw) : bflo(qw), kv = (tl & 1) ? bfhi(kw) : bflo(kw);
      const unsigned kin = cvt_pk(kv * __expf(-run), 0.f) & 0xffffu;
      qdst[(size_t)t * dld] = f2bf(qv * __expf(run) * 0.08838834764831845f);
      kdst[(size_t)t * dld] = (bf16_t)kin;
      if ((j & 1) == 0) kprev = kin;
      else {
        const unsigned pr = DIR ? (kin | (kprev << 16)) : (kprev | (kin << 16));
        *(unsigned*)(skrow + (t & ~1)) = pr;
      }
    }
  }
  return run;
}

__device__ void gla_g1_task(const Params& p, int l, int c, int h, unsigned char* smem) {
  bf16_t* Z = (bf16_t*)(p.ws + OFF_Z);
  bf16_t* Hb = (bf16_t*)(p.ws + OFF_H);
  const bf16_t* GVT = (const bf16_t*)(p.ws + OFF_GVT);
  const float* GA = (const float*)(p.ws + OFF_GA);
  float* DL = (float*)(p.ws + OFF_DL);
  bf16_t* ST = (bf16_t*)(p.ws + OFF_ST);
  const int tid = opaque_tid(), lane = tid & 63, wid = tid >> 6, x = lane & 15, quad = lane >> 4;
  const int dir = tid >> 7, d = tid & 127, row0 = c * 64;
  float* sga = (float*)smem;
  bf16_t* skot = (bf16_t*)(smem + 8192);
  float* sdl = (float*)(smem + 8192 + 36864);
  __syncthreads();
#pragma unroll
  for (int i = 0; i < 2; ++i) { const int id = tid + i * 256; *(f32x4*)(sga + id * 4) = *(const f32x4*)(GA + (size_t)row0 * 32 + id * 4); }
#pragma unroll
  for (int i = 0; i < 8; ++i) {
    const int id = tid + i * 256, which = id >> 10, t = (id >> 4) & 63, ch = id & 15;
    const u32x4 v = *(const u32x4*)(Z + (size_t)(row0 + t) * ZLD + (which ? ZGQ : ZGK) + h * 128 + ch * 8);
    bf16_t* dst = skot + (which * 128 + ch * 8) * 72 + t;
    dst[0 * 72] = (bf16_t)(v.x & 0xffff); dst[1 * 72] = (bf16_t)(v.x >> 16); dst[2 * 72] = (bf16_t)(v.y & 0xffff); dst[3 * 72] = (bf16_t)(v.y >> 16);
    dst[4 * 72] = (bf16_t)(v.z & 0xffff); dst[5 * 72] = (bf16_t)(v.z >> 16); dst[6 * 72] = (bf16_t)(v.w & 0xffff); dst[7 * 72] = (bf16_t)(v.w >> 16);
  }
  float w[16];
#pragma unroll
  for (int r = 0; r < 16; ++r) w[r] = p.w_decay[((size_t)(l * 2 + dir) * 16 + r) * 512 + h * 128 + d];
  const float bias = p.b_decay[(size_t)(l * 2 + dir) * 512 + h * 128 + d];
  __syncthreads();
  u32x4 qrow[8], krow[8];
#pragma unroll
  for (int i = 0; i < 8; ++i) { krow[i] = *(const u32x4*)(skot + (size_t)d * 72 + i * 8); qrow[i] = *(const u32x4*)(skot + (size_t)(128 + d) * 72 + i * 8); }
  asm volatile("s_waitcnt lgkmcnt(0)" ::: "memory");
  __syncthreads();
  bf16_t* qdst = dir ? (Hb + (size_t)row0 * D + h * 128 + d) : (Z + (size_t)row0 * ZLD + ZGQ + h * 128 + d);
  bf16_t* kdst = dir ? (Hb + (size_t)row0 * D + 512 + h * 128 + d) : (Z + (size_t)row0 * ZLD + ZGK + h * 128 + d);
  float run;
  if (dir == 0) run = gla_g1_scan<0>(sga, w, bias, qrow, krow, qdst, kdst, ZLD, skot + (size_t)d * 72);
  else run = gla_g1_scan<1>(sga, w, bias, qrow, krow, qdst, kdst, D, skot + (size_t)(128 + d) * 72);
  const float dlast = __expf(run);
  DL[((size_t)(dir * NCH + c) * 4 + h) * 128 + d] = dlast;
  sdl[dir * 128 + d] = dlast;
  __syncthreads();
  bf16x8 vb[4][2];
#pragma unroll
  for (int jt = 0; jt < 4; ++jt)
#pragma unroll
    for (int kk = 0; kk < 2; ++kk)
      vb[jt][kk] = *(const bf16x8*)(GVT + (size_t)(h * 256 + wid * 64 + jt * 16 + x) * R + row0 + kk * 32 + quad * 8);
#pragma unroll
  for (int dd = 0; dd < 2; ++dd) {
    bf16_t* dst = ST + st_index(dd, c, h);
#pragma unroll
    for (int ih = 0; ih < 2; ++ih) {
      u32x2 pk[4][4];
#pragma unroll
      for (int il = 0; il < 4; ++il) {
        const int it = ih * 4 + il;
        bf16x8 ka[2];
#pragma unroll
        for (int kk = 0; kk < 2; ++kk) ka[kk] = *(const bf16x8*)(skot + (dd * 128 + it * 16 + x) * 72 + kk * 32 + quad * 8);
        const f32x4 sc = *(const f32x4*)(sdl + dd * 128 + it * 16 + quad * 4);
#pragma unroll
        for (int jt = 0; jt < 4; ++jt) {
          f32x4 a = (f32x4){0.f, 0.f, 0.f, 0.f};
          a = mfma16(ka[0], vb[jt][0], a);
          a = mfma16(ka[1], vb[jt][1], a);
          a = a * sc;
          pk[jt][il].x = cvt_pk(a[0], a[1]); pk[jt][il].y = cvt_pk(a[2], a[3]);
        }
      }
      store_tile_bf16(pk, dst + (size_t)(wid * 64) * 128 + ih * 64, 128, smem, wid, lane, 46080u);
    }
  }
}

constexpr int G2_TASKS = 2 * 4 * 32;
constexpr int ATTN_P2 = 48, ATTN_P3 = 512;
__device__ void gla_g2_task(const Params& p, int t) {
  bf16_t* ST = (bf16_t*)(p.ws + OFF_ST);
  const float* DL = (const float*)(p.ws + OFF_DL);
  const int dir = t >> 7, h = (t >> 5) & 3, slab = t & 31;
  const int e0 = (slab * 256 + opaque_tid()) * 4;
  const int dk = e0 & 127;
  f32x4 S = (f32x4){0.f, 0.f, 0.f, 0.f};
  constexpr int BATCH = 10;
  for (int s0 = 0; s0 < NCH; s0 += BATCH) {
    u32x2 kv[BATCH]; f32x4 dl[BATCH];
#pragma unroll
    for (int j = 0; j < BATCH; ++j) {
      const int s = s0 + j;
      const int c = dir ? (259 - s) : (s < 4 ? 256 + s : s - 4);
      kv[j] = *(const u32x2*)(ST + st_index(dir, c, h) + e0);
      dl[j] = *(const f32x4*)(DL + ((size_t)(dir * NCH + c) * 4 + h) * 128 + dk);
    }
#pragma unroll
    for (int j = 0; j < BATCH; ++j) {
      const int s = s0 + j;
      const int c = dir ? (259 - s) : (s < 4 ? 256 + s : s - 4);
      u32x2 w; w.x = cvt_pk(S[0], S[1]); w.y = cvt_pk(S[2], S[3]);
      *(u32x2*)(ST + st_index(dir, c, h) + e0) = w;
      S[0] = S[0] * dl[j][0] + bflo(kv[j].x); S[1] = S[1] * dl[j][1] + bfhi(kv[j].x);
      S[2] = S[2] * dl[j][2] + bflo(kv[j].y); S[3] = S[3] * dl[j][3] + bfhi(kv[j].y);
    }
  }
}

__device__ void gla_g3_task(const Params& p, int l, int c, int h, unsigned char* smem) {
  bf16_t* Z = (bf16_t*)(p.ws + OFF_Z);
  const bf16_t* Hb = (const bf16_t*)(p.ws + OFF_H);
  const bf16_t* GVT = (const bf16_t*)(p.ws + OFF_GVT);
  const bf16_t* ST = (const bf16_t*)(p.ws + OFF_ST);
  const int tid = opaque_tid(), lane = tid & 63, wid = tid >> 6, x = lane & 15, quad = lane >> 4;
  const int row0 = c * 64, toki = wid * 16 + x;
  const bf16_t* Sg0 = ST + st_index(0, c, h) + (size_t)(tid >> 4) * 128 + (((tid & 15) ^ ((tid >> 4) & 15)) * 8);
  const bf16_t* Sg1 = ST + st_index(1, c, h) + (size_t)(tid >> 4) * 128 + (((tid & 15) ^ ((tid >> 4) & 15)) * 8);
  unsigned char* sdst = smem + tid * 16;
  const bf16_t* sp = Sg0;
#define G3_DMA(g) do { if ((g) == 4) sp = Sg1; unsigned char* _d = sdst + ((g) & 3) * 16384; \
    _Pragma("unroll") for (int _i = 0; _i < 4; ++_i) { __builtin_amdgcn_global_load_lds((const unsigned*)(sp), (LAS unsigned*)(_d + _i * 4096), 16, 0, 0); sp += 2048; asm volatile("" : "+v"(sp)); } } while (0)
  __syncthreads();
  G3_DMA(0); G3_DMA(1); G3_DMA(2);
  const bf16_t* qbase0 = Z + (size_t)row0 * ZLD + ZGQ + h * 128;
  const bf16_t* kbase0 = Z + (size_t)row0 * ZLD + ZGK + h * 128;
  const bf16_t* qbase1 = Hb + (size_t)row0 * D + h * 128;
  const bf16_t* kbase1 = Hb + (size_t)row0 * D + 512 + h * 128;
  bf16x8 qb[2][4];
#pragma unroll
  for (int kk = 0; kk < 4; ++kk) {
    qb[0][kk] = *(const bf16x8*)(qbase0 + (size_t)toki * ZLD + kk * 32 + quad * 8);
    qb[1][kk] = *(const bf16x8*)(qbase1 + (size_t)toki * D + kk * 32 + quad * 8);
  }
  f32x4 atot[4];
#pragma unroll
  for (int t = 0; t < 4; ++t) atot[t] = (f32x4){0.f, 0.f, 0.f, 0.f};
#pragma unroll
  for (int dir = 0; dir < 2; ++dir) {
    const bf16_t* kb = dir ? kbase1 : kbase0;
    const int ld = dir ? D : ZLD;
    bf16x8 kf[4][4];
#pragma unroll
    for (int t = 0; t < 4; ++t)
#pragma unroll
      for (int kk = 0; kk < 4; ++kk) kf[t][kk] = *(const bf16x8*)(kb + (size_t)(t * 16 + x) * ld + kk * 32 + quad * 8);
#pragma unroll
    for (int t = 0; t < 4; ++t) {
      f32x4 a = (f32x4){0.f, 0.f, 0.f, 0.f};
#pragma unroll
      for (int kk = 0; kk < 4; ++kk) a = mfma16(kf[t][kk], qb[dir][kk], a);
#pragma unroll
      for (int r = 0; r < 4; ++r) {
        const int tokj = t * 16 + quad * 4 + r;
        const bool keep = dir ? (tokj >= toki) : (tokj <= toki);
        atot[t][r] += keep ? a[r] : 0.f;
      }
    }
    __builtin_amdgcn_sched_barrier(0);
  }
  f32x4 o[16];
#pragma unroll
  for (int dt = 0; dt < 16; ++dt) o[dt] = (f32x4){0.f, 0.f, 0.f, 0.f};
  const unsigned lbase = (unsigned)(size_t)(const LAS unsigned char*)smem;
  unsigned akk[4];
#pragma unroll
  for (int kk = 0; kk < 4; ++kk) akk[kk] = lbase + (unsigned)(x * 256 + (((kk * 4 + quad) ^ x) << 4));
#pragma unroll
  for (int g = 0; g < 8; ++g) {
    if (g < 6) asm volatile("s_waitcnt vmcnt(8)" ::: "memory"); else if (g == 6) asm volatile("s_waitcnt vmcnt(4)" ::: "memory"); else asm volatile("s_waitcnt vmcnt(0)" ::: "memory");
    __builtin_amdgcn_s_barrier(); asm volatile("" ::: "memory");
    if (g + 3 < 8) G3_DMA(g + 3);
    const int dir = g >> 2;
#pragma unroll
    for (int half = 0; half < 2; ++half) {
      bf16x8 sf[2][4];
#pragma unroll
      for (int dl = 0; dl < 2; ++dl)
#pragma unroll
        for (int kk = 0; kk < 4; ++kk)
          asm volatile("ds_read_b128 %0, %1 offset:%2" : "=v"(sf[dl][kk]) : "v"(akk[kk]), "n"((g & 3) * 16384 + (half * 2 + dl) * 4096));
      asm volatile("s_waitcnt lgkmcnt(0)" : "+v"(sf[0][0]), "+v"(sf[0][1]), "+v"(sf[0][2]), "+v"(sf[0][3]), "+v"(sf[1][0]), "+v"(sf[1][1]), "+v"(sf[1][2]), "+v"(sf[1][3]));
#pragma unroll
      for (int dl = 0; dl < 2; ++dl) {
        const int dt = (g & 3) * 4 + half * 2 + dl;
#pragma unroll
        for (int kk = 0; kk < 4; ++kk) o[dt] = mfma16(sf[dl][kk], qb[dir][kk], o[dt]);
      }
    }
  }
#undef G3_DMA
  bf16x8 pb[2];
#pragma unroll
  for (int hh = 0; hh < 2; ++hh) {
    u32x4 w;
    w.x = cvt_pk(atot[2 * hh][0], atot[2 * hh][1]); w.y = cvt_pk(atot[2 * hh][2], atot[2 * hh][3]);
    w.z = cvt_pk(atot[2 * hh + 1][0], atot[2 * hh + 1][1]); w.w = cvt_pk(atot[2 * hh + 1][2], atot[2 * hh + 1][3]);
    pb[hh] = __builtin_bit_cast(bf16x8, w);
  }
  {
    const bf16_t* vbase = GVT + (size_t)(h * 256 + x) * R + row0 + quad * 4;
#pragma unroll
    for (int vh = 0; vh < 2; ++vh) {
      u32x2 vf[8][4];
#pragma unroll
      for (int d8 = 0; d8 < 8; ++d8)
#pragma unroll
        for (int m = 0; m < 4; ++m) vf[d8][m] = *(const u32x2*)(vbase + (size_t)((vh * 8 + d8) * 16) * R + m * 16);
#pragma unroll
      for (int d8 = 0; d8 < 8; ++d8)
#pragma unroll
        for (int hh = 0; hh < 2; ++hh) {
          u32x4 w; w.x = vf[d8][2 * hh].x; w.y = vf[d8][2 * hh].y; w.z = vf[d8][2 * hh + 1].x; w.w = vf[d8][2 * hh + 1].y;
          o[vh * 8 + d8] = mfma16(__builtin_bit_cast(bf16x8, w), pb[hh], o[vh * 8 + d8]);
        }
      __builtin_amdgcn_sched_barrier(0);
    }
  }
  float ss = 0.f;
#pragma unroll
  for (int dt = 0; dt < 16; ++dt) ss += o[dt][0] * o[dt][0] + o[dt][1] * o[dt][1] + o[dt][2] * o[dt][2] + o[dt][3] * o[dt][3];
  ss += __shfl_xor(ss, 16); ss += __shfl_xor(ss, 32);
  const float rstd = rsqrtf(ss * (1.0f / 256.0f) + EPS);
  const float* gain = p.gla_gain + l * 256 + quad * 4;
  __builtin_amdgcn_s_barrier();
  asm volatile("" ::: "memory");
  unsigned char* sw = smem + wid * 8448;
  bf16_t* grow = Z + (size_t)(row0 + wid * 16) * ZLD + ZGR + h * 256;
  {
    u32x4 gt[8];
#pragma unroll
    for (int it = 0; it < 8; ++it) gt[it] = *(const u32x4*)(grow + (size_t)(it * 2 + (lane >> 5)) * ZLD + (lane & 31) * 8);
#pragma unroll
    for (int it = 0; it < 8; ++it) *(u32x4*)(sw + (it * 2 + (lane >> 5)) * 528 + (lane & 31) * 16) = gt[it];
  }
  unsigned char* mine = sw + x * 528 + quad * 8;
#pragma unroll
  for (int dt = 0; dt < 16; ++dt) {
    const f32x4 gn = *(const f32x4*)(gain + dt * 16);
    const u32x2 gg = *(const u32x2*)(mine + dt * 32);
    const float y0 = o[dt][0] * rstd * gn[0] * siluf_(bflo(gg.x)), y1 = o[dt][1] * rstd * gn[1] * siluf_(bfhi(gg.x));
    const float y2 = o[dt][2] * rstd * gn[2] * siluf_(bflo(gg.y)), y3 = o[dt][3] * rstd * gn[3] * siluf_(bfhi(gg.y));
    u32x2 w; w.x = cvt_pk(y0, y1); w.y = cvt_pk(y2, y3);
    *(u32x2*)(mine + dt * 32) = w;
  }
#pragma unroll
  for (int it = 0; it < 8; ++it) {
    const u32x4 v = *(const u32x4*)(sw + (it * 2 + (lane >> 5)) * 528 + (lane & 31) * 16);
    *(u32x4*)(grow + (size_t)(it * 2 + (lane >> 5)) * ZLD + (lane & 31) * 8) = v;
  }
}


#define XB_TMO      128
#define XB_XCNT(j)  (256  + 64 * (j))
#define XB_XSUB(j)  (1280 + 64 * (j))
#define XB_XGEN(j)  (2304 + 64 * (j))
#define XB_TOP      3328
#define XB_TOPGEN   3392
#define XCD_BAR_WORDS 3456
#define XB_SPIN_CAP (1u << 22)
__device__ __forceinline__ unsigned xb_ld(unsigned* p)              { return __hip_atomic_load(p, __ATOMIC_RELAXED, __HIP_MEMORY_SCOPE_AGENT); }
__device__ __forceinline__ unsigned xb_add(unsigned* p, unsigned v) { return __hip_atomic_fetch_add(p, v, __ATOMIC_RELAXED, __HIP_MEMORY_SCOPE_AGENT); }
__device__ __forceinline__ unsigned xb_xcc_id() { return (unsigned)__builtin_amdgcn_s_getreg((3 << 11) | 20) & 0xFu; }
#define XB_SPIN(cond, bar) do { unsigned _sp = 0; while (cond) { __builtin_amdgcn_s_sleep(1); \
    if ((++_sp & 255u) == 0u) { if (xb_ld(&(bar)[XB_TMO])) break; if (_sp > XB_SPIN_CAP) { atomicAdd(&(bar)[XB_TMO], 1u); break; } } } } while (0)
struct XcdBarrier { unsigned* bar; unsigned x; volatile LAS unsigned* st; };
__device__ __forceinline__ XcdBarrier xcd_barrier_post(unsigned* bar, volatile LAS unsigned* st) {
  XcdBarrier b; b.bar = bar; b.x = xb_xcc_id(); b.st = st;
  if (threadIdx.x == 0) (void)xb_add(&bar[XB_XCNT(b.x)], 1u);
  return b;
}
__device__ __forceinline__ void xcd_barrier_complete(unsigned* bar, unsigned x, unsigned& nloc, unsigned& nx) {
  const unsigned G = gridDim.x * gridDim.y * gridDim.z;
  unsigned sum, cnt, mine, sp = 0u;
  for (;;) {
    sum = 0u; cnt = 0u; mine = 0u;
#pragma unroll
    for (unsigned j = 0; j < 16; ++j) { const unsigned c = xb_ld(&bar[XB_XCNT(j)]); sum += c; cnt += (c > 0u) ? 1u : 0u; mine = (j == x) ? c : mine; }
    if (sum == G) break;
    __builtin_amdgcn_s_sleep(1);
    if ((++sp & 255u) == 0u) { if (xb_ld(&bar[XB_TMO])) break; if (sp > XB_SPIN_CAP) { atomicAdd(&bar[XB_TMO], 1u); break; } }
  }
  nloc = mine > 0u ? mine : 1u; nx = cnt > 0u ? cnt : 1u;
}
__device__ __forceinline__ void xcd_barrier(const XcdBarrier& b) {
  asm volatile("s_waitcnt vmcnt(0)" ::: "memory");
  __syncthreads();
  if (threadIdx.x == 0) {
    unsigned* bar = b.bar;
    __builtin_amdgcn_s_waitcnt(0);
    unsigned nloc = b.st[0], nx = b.st[1];
    if (nloc == 0u) { xcd_barrier_complete(bar, b.x, nloc, nx); b.st[0] = nloc; b.st[1] = nx; }
    const unsigned old = xb_add(&bar[XB_XSUB(b.x)], 1u);
    const unsigned gen = old / nloc;
    if (old + 1u == (gen + 1u) * nloc) {
      __builtin_amdgcn_fence(__ATOMIC_RELEASE, "agent");
      asm volatile("s_waitcnt vmcnt(0)" ::: "memory");
      const unsigned og = xb_add(&bar[XB_TOP], 1u);
      const unsigned tg = og / nx;
      if (og + 1u == (tg + 1u) * nx) xb_add(&bar[XB_TOPGEN], 1u);
      else XB_SPIN(xb_ld(&bar[XB_TOPGEN]) == tg, bar);
      __builtin_amdgcn_fence(__ATOMIC_ACQUIRE, "agent");
      xb_add(&bar[XB_XGEN(b.x)], 1u);
      asm volatile("s_waitcnt vmcnt(0)" ::: "memory");
    } else {
      XB_SPIN(xb_ld(&bar[XB_XGEN(b.x)]) == gen, bar);
      __builtin_amdgcn_fence(__ATOMIC_ACQUIRE, "agent");
      asm volatile("s_waitcnt vmcnt(0)" ::: "memory");
    }
  }
  __syncthreads();
}

#ifndef DIS
#define DIS 0
#endif
#ifndef PROBE_MASK
#define PROBE_MASK 0
#endif
constexpr int LDS_BYTES = 65536;
constexpr int PH_PER_LAYER = 10;
constexpr int NPHASES = 1 + DEPTH * PH_PER_LAYER;

__global__ void __launch_bounds__(256, 2) mk(Params p, int ph_lo, int ph_hi, int coop) {
  __shared__ __attribute__((aligned(16))) unsigned char smem[LDS_BYTES];
  __shared__ uint4 xb_words;
  cg::grid_group grid = cg::this_grid();
  if (coop == 2) grid.sync();
  const int G = gridDim.x, b = blockIdx.x;
  if (threadIdx.x == 0) xb_words = make_uint4(0u, 0u, 0u, 0u);
  __syncthreads();
  XcdBarrier xb = xcd_barrier_post((unsigned*)(p.ws + OFF_BAR), (volatile LAS unsigned*)&xb_words);
#if PROBE_MASK
  unsigned long long tprev = __builtin_amdgcn_s_memrealtime(), tacc = 0ull;
#endif
  for (int ph = ph_lo; ph < ph_hi; ++ph) {
    if (coop && ph > ph_lo) {
      xcd_barrier(xb);
#if PROBE_MASK
      { const unsigned long long tn = __builtin_amdgcn_s_memrealtime(); const int pp = ph - 1; const int kind = pp == 0 ? 10 : (pp - 1) % PH_PER_LAYER;
        if ((PROBE_MASK >> kind) & 1) tacc += tn - tprev; tprev = tn; }
#endif
    }
    if (ph == 0) {
      for (int i = b * 256 + opaque_tid(); i < LCTX * D / 4; i += G * 256) ((f32x4*)(p.ws + OFF_XC))[i] = ((const f32x4*)p.ctx)[i];
      for (int t = b; t < MOD_TASKS + 16; t += G) {
        if (t < MOD_TASKS) { if (!(DIS & 1)) mod_task(p, t, smem); }
        else rope_task(p, t - MOD_TASKS);
      }
      continue;
    }
    const int l = (ph - 1) / PH_PER_LAYER, s = (ph - 1) % PH_PER_LAYER;
    const bool last = l == DEPTH - 1;
    const float* xlat = l == 0 ? p.x : p.out;
    const float* xctx = (const float*)(p.ws + OFF_XC);
    const int ntm = last ? (NTOK / 128) : (R / 128);
    switch (s) {
      case 0: {
        const int ncv = CV_TOTAL;
        for (int t = b; t < R / 16 + ncv; t += G) {
          if (t < R / 16) norm_task(p, l, t, 0, xlat, xctx);
          else { if (!(DIS & 2)) convert_task(p, l, t - R / 16, smem); }
        }
      } break;
      case 1: if (!(DIS & 4)) phase_gemm_in(p, l, smem); break;
      case 2: case 3: case 4: {
        const int nattn_all = (last ? NTOK / 128 : R / 128) * 16;
        const int nfirst = (s == 2) ? NCH * 4 : (s == 3) ? G2_TASKS : (last ? 256 : NCH) * 4;
        const int p4 = nattn_all - ATTN_P2 - ATTN_P3;
        const int a_lo = (s == 2) ? 0 : (s == 3) ? ATTN_P2 : ATTN_P2 + ATTN_P3;
        const int na = (s == 2) ? ATTN_P2 : (s == 3) ? ATTN_P3 : p4;
        const int tstride = (s == 3 && G == 512) ? (b < 256 ? (1 << 28) : 256) : G;
        for (int t = b; t < nfirst + na; t += tstride) {
          if (t < nfirst) {
            if (s == 2) gla_g1_task(p, l, t >> 2, t & 3, smem);
            else if (s == 3) gla_g2_task(p, t);
            else gla_g3_task(p, l, t >> 2, t & 3, smem);
          } else { const int a = a_lo + (t - nfirst); attn_task(p, l, a >> 4, a & 15, smem); }
        }
      } break;
      case 5: if (!(DIS & 128)) phase_gemm<0>(p, l, ntm, nullptr, 0, nullptr, D, 8, 0, nullptr, nullptr, smem); break;
      case 6: if (!(DIS & 256)) phase_gemm<1>(p, l, ntm, (const bf16_t*)(p.ws + OFF_H), D, (const bf16_t*)(p.ws + OFF_WO), D, 8, 2, xlat, xctx, smem); break;
      case 7: for (int t = b; t < ntm * 8; t += G) norm_task(p, l, t, 1, p.out, (const float*)(p.ws + OFF_XC)); break;
      case 8: if (!(DIS & 512)) phase_gemm<2>(p, l, ntm, (const bf16_t*)(p.ws + OFF_H), D, (const bf16_t*)(p.ws + OFF_WF1), D, 32, 0, nullptr, nullptr, smem); break;
      case 9: if (!(DIS & 256)) phase_gemm<1>(p, l, ntm, (const bf16_t*)(p.ws + OFF_Z), DFF, (const bf16_t*)(p.ws + OFF_WF2), DFF, 8, 5, p.out, (const float*)(p.ws + OFF_XC), smem); break;
    }
  }
#if PROBE_MASK
  if (b == 0) {
    { const unsigned long long tn = __builtin_amdgcn_s_memrealtime(); if ((PROBE_MASK >> 9) & 1) tacc += tn - tprev; tprev = tn; }
    const unsigned long long t0 = __builtin_amdgcn_s_memrealtime();
    while (__builtin_amdgcn_s_memrealtime() - t0 < 4ull * tacc) __builtin_amdgcn_s_sleep(8);
  }
#endif
}

#ifndef MULTI_LAUNCH
#define MULTI_LAUNCH 0
#endif

extern "C" void kernel_launch(void* const* d_in, const int* in_sizes, int n_in, void* d_out, int out_size,
                              void* d_ws, size_t ws_size, hipStream_t stream) {
  static int grid_blocks = 0;
  if (!grid_blocks) {
    int dev = 0, cus = 0, per_cu = 0;
    (void)hipGetDevice(&dev);
    (void)hipDeviceGetAttribute(&cus, hipDeviceAttributeMultiprocessorCount, dev);
    (void)hipOccupancyMaxActiveBlocksPerMultiprocessor(&per_cu, mk, 256, 0);
    if (per_cu > 2) per_cu = 2;
    if (per_cu < 1) per_cu = 1;
    grid_blocks = cus * per_cu;
  }
  if (ws_size < WS_NEED) { fprintf(stderr, "workspace too small: %zu < %zu\n", ws_size, (size_t)WS_NEED); return; }
  Params p{};
  const float** f = (const float**)&p;
  for (int i = 0; i < 20; ++i) f[i] = (const float*)d_in[i];
  p.out = (float*)d_out;
  p.ws = (unsigned char*)d_ws;
  (void)hipMemsetAsync((unsigned char*)d_ws + OFF_BAR, 0, XCD_BAR_WORDS * 4, stream);
#if MULTI_LAUNCH
  for (int ph = 0; ph < NPHASES; ++ph) {
    int lo = ph, hi = ph + 1, coop = 0;
    hipLaunchKernelGGL(mk, dim3(grid_blocks), dim3(256), 0, stream, p, lo, hi, coop);
  }
#else
  int lo = 0, hi = NPHASES, coop = 1;
  void* args[] = {&p, &lo, &hi, &coop};
  hipError_t e = hipLaunchCooperativeKernel((void*)mk, dim3(grid_blocks), dim3(256), args, 0, stream);
  if (e != hipSuccess) fprintf(stderr, "cooperative launch failed: %s (grid %d)\n", hipGetErrorString(e), grid_blocks);
#endif
}
```
